# Optimizing an MI355X kernel written in HIP

```python
import math
import jax, jax.numpy as jnp
from jax import lax
import numpy as np

D_MODEL = 1024
BATCH = 8
SEQ = 4096
DEPTH = 4

A_HEADS = 8
A_HEAD_DIM = 64
A_WIDTH = A_HEADS * A_HEAD_DIM
DILATED_PATTERNS = ((128, 1), (512, 4), (2048, 16))
MLA_HEADS = 4
QK_NOPE = 128
QK_ROPE = 64
V_DIM = 128
Q_LORA = 256
KV_LORA = 128
MLA_WIDTH = MLA_HEADS * V_DIM
MIX_WIDTH = A_WIDTH + MLA_WIDTH
IN_COLS = 3 * A_WIDTH + Q_LORA + KV_LORA + QK_ROPE
Q_BLOCK = 128
D_FF = 4 * D_MODEL
ROPE_THETA = 10000.0
ALPHA = (2.0 * DEPTH) ** 0.25
BETA_INIT = (8.0 * DEPTH) ** -0.25
LN_EPS = 1e-5
RMS_EPS = 1e-6

kernel_name = 'hybrid_dilated_mla_deepnorm'


def _layer_norm(x, g, b):
    x32 = x.astype(jnp.float32)
    mu = jnp.mean(x32, -1, keepdims=True)
    var = jnp.mean(jnp.square(x32 - mu), -1, keepdims=True)
    y = (x32 - mu) * lax.rsqrt(var + LN_EPS)
    return (y * g.astype(jnp.float32) + b.astype(jnp.float32)).astype(x.dtype)


def _rms_norm(x, g):
    x32 = x.astype(jnp.float32)
    y = x32 * lax.rsqrt(jnp.mean(jnp.square(x32), -1, keepdims=True) + RMS_EPS)
    return (y * g.astype(jnp.float32)).astype(x.dtype)


def _rope(x, pos):
    half = x.shape[-1] // 2
    inv_freq = ROPE_THETA ** (-jnp.arange(half, dtype=jnp.float32) / half)
    ang = pos.astype(jnp.float32)[:, None] * inv_freq[None, :]
    cos = jnp.cos(ang)[None, :, None, :]
    sin = jnp.sin(ang)[None, :, None, :]
    x1 = x[..., :half].astype(jnp.float32)
    x2 = x[..., half:].astype(jnp.float32)
    return jnp.concatenate([x1 * cos - x2 * sin, x2 * cos + x1 * sin], -1).astype(x.dtype)


def _dilated_window_attention(q, k, v, window, dilation):
    B, S, H, D = q.shape
    span = window // dilation
    L = S // dilation
    nb = -(-L // span)
    Lp = nb * span

    def to_sub(t):
        t = t.reshape(B, L, dilation, H, D).transpose(0, 2, 1, 3, 4).reshape(B * dilation, L, H, D)
        t = jnp.pad(t, ((0, 0), (0, Lp - L), (0, 0), (0, 0)))
        return t.reshape(B * dilation, nb, span, H, D)

    def band(tb):
        prev = jnp.pad(tb[:, :-1], ((0, 0), (1, 0), (0, 0), (0, 0), (0, 0)))
        return jnp.concatenate([prev, tb], axis=2)

    qb = to_sub(q)
    kb = band(to_sub(k))
    vb = band(to_sub(v))
    s = jnp.einsum('znqhd,znkhd->znhqk', qb, kb).astype(jnp.float32) * (D ** -0.5)
    qi = jnp.arange(span)[:, None]
    kj = jnp.arange(2 * span)[None, :]
    dist = span + qi - kj
    in_band = (dist >= 0) & (dist <= span)
    has_prev = (jnp.arange(nb)[:, None, None] > 0) | (kj >= span)[None]
    mask = (in_band[None] & has_prev)[None, :, None]
    s = jnp.where(mask, s, -jnp.inf)
    m = jnp.max(s, -1, keepdims=True)
    p = jnp.exp(s - m)
    den = jnp.sum(p, -1, keepdims=True)
    o = jnp.einsum('znhqk,znkhd->znqhd', (p / den).astype(v.dtype), vb)
    lse = (m + jnp.log(den))[..., 0].transpose(0, 1, 3, 2)

    def from_sub(t):
        t = t.reshape((B * dilation, Lp) + t.shape[3:])[:, :L]
        t = t.reshape((B, dilation, L) + t.shape[2:])
        t = jnp.moveaxis(t, 1, 2)
        return t.reshape((B, S) + t.shape[3:])

    return from_sub(o), from_sub(lse)


def _dilated_mixture(q, k, v):
    outs, lses = [], []
    for window, dilation in DILATED_PATTERNS:
        o, lse = _dilated_window_attention(q, k, v, window, dilation)
        outs.append(o)
        lses.append(lse)
    w = jax.nn.softmax(jnp.stack(lses), axis=0)
    o = jnp.sum(w[..., None] * jnp.stack(outs).astype(jnp.float32), axis=0)
    return o.astype(q.dtype)


def _mla_attention(c_q, c_kv, k_r, q_a_g, kv_a_g, w_uq, w_ukv, pos):
    B, S, _ = c_q.shape
    q = jnp.einsum('bsr,re->bse', _rms_norm(c_q, q_a_g), w_uq).reshape(B, S, MLA_HEADS, QK_NOPE + QK_ROPE)
    q_nope, q_pe = q[..., :QK_NOPE], q[..., QK_NOPE:]
    q_pe = _rope(q_pe, pos)
    kv = jnp.einsum('bsr,re->bse', _rms_norm(c_kv, kv_a_g), w_ukv).reshape(B, S, MLA_HEADS, QK_NOPE + V_DIM)
    k_nope, v = kv[..., :QK_NOPE], kv[..., QK_NOPE:]
    k_pe = _rope(k_r[:, :, None, :], pos)
    q_full = jnp.concatenate([q_nope, q_pe], -1)
    k_full = jnp.concatenate([k_nope, jnp.broadcast_to(k_pe, (B, S, MLA_HEADS, QK_ROPE))], -1)
    scale = (QK_NOPE + QK_ROPE) ** -0.5
    nq = S // Q_BLOCK
    qb = q_full.reshape(B, nq, Q_BLOCK, MLA_HEADS, QK_NOPE + QK_ROPE).transpose(1, 0, 2, 3, 4)
    kpos = jnp.arange(S)

    def one_block(args):
        i, qblk = args
        s = jnp.einsum('bqhd,bkhd->bhqk', qblk, k_full).astype(jnp.float32) * scale
        qpos = i * Q_BLOCK + jnp.arange(Q_BLOCK)
        s = jnp.where(kpos[None, :] <= qpos[:, None], s, -jnp.inf)
        p = jax.nn.softmax(s, axis=-1)
        return jnp.einsum('bhqk,bkhd->bqhd', p.astype(v.dtype), v)

    o = lax.map(one_block, (jnp.arange(nq), qb))
    return o.transpose(1, 0, 2, 3, 4).reshape(B, S, MLA_WIDTH)


def setup_inputs(seed: int = 0) -> dict:
    key = jax.random.key(seed)
    ks = jax.random.split(key, 16)

    def nrm(k, shape, scale):
        return jax.random.normal(k, shape, jnp.float32) * scale

    return {
        'x': nrm(ks[0], (BATCH, SEQ, D_MODEL), 1.0),
        'w_in': nrm(ks[1], (DEPTH, D_MODEL, IN_COLS), D_MODEL ** -0.5),
        'q_a_norm': 1.0 + nrm(ks[2], (DEPTH, Q_LORA), 0.02),
        'kv_a_norm': 1.0 + nrm(ks[3], (DEPTH, KV_LORA), 0.02),
        'w_uq': nrm(ks[4], (DEPTH, Q_LORA, MLA_HEADS * (QK_NOPE + QK_ROPE)), Q_LORA ** -0.5),
        'w_ukv': nrm(ks[5], (DEPTH, KV_LORA, MLA_HEADS * (QK_NOPE + V_DIM)), KV_LORA ** -0.5),
        'a_out_norm': 1.0 + nrm(ks[6], (DEPTH, A_WIDTH), 0.02),
        'b_out_norm': 1.0 + nrm(ks[7], (DEPTH, MLA_WIDTH), 0.02),
        'w_o': nrm(ks[8], (DEPTH, MIX_WIDTH, D_MODEL), MIX_WIDTH ** -0.5 * BETA_INIT),
        'ln1_g': 1.0 + nrm(ks[9], (DEPTH, D_MODEL), 0.02),
        'ln1_b': nrm(ks[10], (DEPTH, D_MODEL), 0.02),
        'w_ff1': nrm(ks[11], (DEPTH, D_MODEL, D_FF), D_MODEL ** -0.5),
        'w_ff2': nrm(ks[12], (DEPTH, D_FF, D_MODEL), D_FF ** -0.5 * BETA_INIT),
        'ln2_g': 1.0 + nrm(ks[13], (DEPTH, D_MODEL), 0.02),
        'ln2_b': nrm(ks[14], (DEPTH, D_MODEL), 0.02),
    }


def reference(x, w_in, q_a_norm, kv_a_norm, w_uq, w_ukv, a_out_norm, b_out_norm, w_o,
              ln1_g, ln1_b, w_ff1, w_ff2, ln2_g, ln2_b):
    B, S, _ = x.shape
    pos = jnp.arange(S, dtype=jnp.int32)
    splits = [A_WIDTH, 2 * A_WIDTH, 3 * A_WIDTH, 3 * A_WIDTH + Q_LORA, 3 * A_WIDTH + Q_LORA + KV_LORA]
    for l in range(DEPTH):
        h = jnp.einsum('bsd,de->bse', x, w_in[l])
        qa, ka, va, c_q, c_kv, k_r = jnp.split(h, splits, axis=-1)
        qa = _rope(qa.reshape(B, S, A_HEADS, A_HEAD_DIM), pos)
        ka = _rope(ka.reshape(B, S, A_HEADS, A_HEAD_DIM), pos)
        va = va.reshape(B, S, A_HEADS, A_HEAD_DIM)
        a_out = _dilated_mixture(qa, ka, va).reshape(B, S, A_WIDTH)
        b_out = _mla_attention(c_q, c_kv, k_r, q_a_norm[l], kv_a_norm[l], w_uq[l], w_ukv[l], pos)
        mixed = jnp.concatenate([_rms_norm(a_out, a_out_norm[l]), _rms_norm(b_out, b_out_norm[l])], -1)
        y = jnp.einsum('bse,ed->bsd', mixed, w_o[l])
        x = _layer_norm(ALPHA * x + y, ln1_g[l], ln1_b[l])
        f = jnp.square(jax.nn.relu(jnp.einsum('bsd,df->bsf', x, w_ff1[l])))
        f = jnp.einsum('bsf,fd->bsd', f, w_ff2[l])
        x = _layer_norm(ALPHA * x + f, ln2_g[l], ln2_b[l])
    return x
```

```cpp
#include <hip/hip_runtime.h>
#include <hip/hip_cooperative_groups.h>
#include <cstdio>
#include <cstdint>
namespace cg = cooperative_groups;

#ifndef DUP_MASK
#define DUP_MASK 0
#endif
#ifndef PH_MASK
#define PH_MASK 1023
#endif
#ifndef USE_XCD_BARRIER
#define USE_XCD_BARRIER 1
#endif

__device__ __forceinline__ int lane_id_v() { int l; asm volatile("v_mbcnt_lo_u32_b32 %0, -1, 0\n\tv_mbcnt_hi_u32_b32 %0, -1, %0" : "=v"(l)); return l; }
namespace pg8 {
#define PG8_LAS __attribute__((address_space(3)))
typedef unsigned short bf16_t;
typedef short bf16x8 __attribute__((ext_vector_type(8)));
typedef float f32x4 __attribute__((ext_vector_type(4)));
typedef unsigned u32x4 __attribute__((ext_vector_type(4)));
typedef unsigned u32x2 __attribute__((ext_vector_type(2)));
constexpr int BM = 256, BK = 64, HALF = 128, HTB = HALF * BK * 2, STAGE_BYTES = 8 * HTB, NXCD = 8, WGM = 8;

__host__ __device__ __forceinline__ int lds_byte(int r, int c) { const int st = (r >> 4) * 2 + (c >> 5), rr = r & 15, cc = c & 31, ob = rr * 64 + cc * 2; return st * 1024 + (ob ^ (((ob >> 9) & 1) << 5)); }
__host__ __device__ __forceinline__ void stage_rc(int b, int& R, int& C) { const int st = b / 1024, sb = b % 1024, swz = sb ^ (((sb >> 9) & 1) << 5); R = (st >> 1) * 16 + swz / 64; C = (st & 1) * 32 + (swz % 64) / 2; }
__host__ __device__ __forceinline__ int perm32(int rho) { const int n = rho >> 4, i = rho & 15; return 8 * (i >> 2) + 4 * n + (i & 3); }

struct Unit { int pm, pn; };
struct Gemm { const bf16_t* A; const bf16_t* Bt; int M, N, K; };

struct StaticOrder {
    int nM, nN, nwg, G, c;
    __host__ __device__ void init(int M, int N, int G_, int c_) { nM = M / BM; nN = N / BM; nwg = nM * nN; G = G_; c = c_; }
    __host__ __device__ bool next(int i, Unit& u) const {
        const long L = (long)i * G + c; if (L >= nwg) return false;
        int wgid = (int)L; { const int q = nwg / NXCD, r = nwg % NXCD, xcd = wgid % NXCD, off = wgid / NXCD; wgid = (xcd < r ? xcd * (q + 1) : r * (q + 1) + (xcd - r) * q) + off; }
        const int nig = WGM * nN, gid = wgid / nig, fm = gid * WGM, gsz = (nM - fm) < WGM ? (nM - fm) : WGM;
        u.pm = fm + ((wgid % nig) % gsz); u.pn = (wgid % nig) / gsz; return true;
    }
};

__device__ __forceinline__ unsigned cvt_pk_bf16(float lo, float hi) { unsigned r; asm volatile("v_cvt_pk_bf16_f32 %0, %1, %2" : "=v"(r) : "v"(lo), "v"(hi)); return r; }

template <class Epi, class Sched, bool ALIGN_EPI = false, bool SP2 = false>
__device__ __forceinline__ void gemm_phase(PG8_LAS unsigned char* lds, const Gemm g, const Sched& S, const Epi& E, int wv) {
    int tid_o = wv * 64 + lane_id_v(); asm volatile("" : "+v"(tid_o));
    const int tid = tid_o, wid = __builtin_amdgcn_readfirstlane(tid >> 6), lane = tid & 63, wr = wid >> 2, wc = wid & 3, fr = lane & 15, fq = lane >> 4;
    const int K = g.K, nt = K / BK;
    unsigned voffA[2], voffB[2];
#pragma unroll
    for (int i = 0; i < 2; ++i) { int R, C; stage_rc(tid * 16 + i * 8192, R, C); const int Rb = Epi::PERM ? ((R & ~31) + perm32(R & 31)) : R;
        voffA[i] = (unsigned)(R * K + C) * 2u; voffB[i] = (unsigned)(Rb * K + C) * 2u; }
    const size_t kstep = (size_t)(BK * 2);
    const size_t hstep = (size_t)HALF * K * 2;
    const size_t tstep = 2 * hstep;
    const unsigned ldsw = (unsigned)wid * 1024u;
    const int aoff = lds_byte(wr * 64 + fr, fq * 8), boff = lds_byte(wc * 32 + fr, fq * 8);
#define PG8_SA(b, h) (((b) * 2 + (h)) * HTB)
#define PG8_SB(b, h) ((4 + (b) * 2 + (h)) * HTB)
#define PG8_STAGE(bufoff, gbase, voff) do { _Pragma("unroll") for (int _i = 0; _i < 2; ++_i) \
        __builtin_amdgcn_global_load_lds((const unsigned*)((const char*)(gbase) + (voff)[_i]), (PG8_LAS unsigned*)(lds + (bufoff) + ldsw + _i * 8192), 16, 0, 0); } while (0)
#define PG8_LDA(dst, b, h) do { _Pragma("unroll") for (int m = 0; m < 4; ++m) _Pragma("unroll") for (int k = 0; k < 2; ++k) dst[m][k] = *(const PG8_LAS bf16x8*)(lds + PG8_SA(b, h) + aoff + m * 2048 + k * 1024); } while (0)
#define PG8_LDB(dst, b, h) do { _Pragma("unroll") for (int n = 0; n < 2; ++n) _Pragma("unroll") for (int k = 0; k < 2; ++k) dst[n][k] = *(const PG8_LAS bf16x8*)(lds + PG8_SB(b, h) + boff + n * 2048 + k * 1024); } while (0)
#define PG8_MMA(ai, bj, At, Bt) do { __builtin_amdgcn_s_setprio(1); _Pragma("unroll") for (int m = 0; m < 4; ++m) _Pragma("unroll") for (int n = 0; n < 2; ++n) _Pragma("unroll") for (int k = 0; k < 2; ++k) \
        acc[ai][bj][m][n] = __builtin_amdgcn_mfma_f32_16x16x32_bf16(Bt[n][k], At[m][k], acc[ai][bj][m][n], 0, 0, 0); __builtin_amdgcn_s_setprio(0); } while (0)
#define PG8_WAIT_V(n) asm volatile("s_waitcnt vmcnt(" #n ")" ::: "memory")
#define PG8_WAIT_L(n) asm volatile("s_waitcnt lgkmcnt(" #n ")" ::: "memory")
#define PG8_BAR __builtin_amdgcn_s_barrier()
#define PG8_SCHED __builtin_amdgcn_sched_barrier(0)
    Unit cur, nxt; int ui = 0;
    if (!S.next(0, cur)) return;
    f32x4 acc[2][2][4][2];
#pragma unroll
    for (int a = 0; a < 2; ++a)
#pragma unroll
        for (int b = 0; b < 2; ++b)
#pragma unroll
            for (int m = 0; m < 4; ++m)
#pragma unroll
                for (int n = 0; n < 2; ++n) acc[a][b][m][n] = (f32x4){0.f, 0.f, 0.f, 0.f};
    bf16x8 At[4][2], B0[2][2], B1[2][2];
    const char* cA = (const char*)g.A + (size_t)cur.pm * tstep; const char* cB = (const char*)g.Bt + (size_t)cur.pn * tstep;
    if constexpr (SP2) {
        PG8_STAGE(PG8_SB(0, 0), cB, voffB); PG8_STAGE(PG8_SB(0, 1), cB + hstep, voffB); PG8_STAGE(PG8_SA(0, 0), cA, voffA); PG8_STAGE(PG8_SA(0, 1), cA + hstep, voffA);
        if (wr == 1) PG8_BAR;
        PG8_WAIT_V(2); PG8_BAR;
        PG8_STAGE(PG8_SB(1, 0), cB + kstep, voffB); PG8_STAGE(PG8_SA(1, 0), cA + kstep, voffA); PG8_STAGE(PG8_SB(1, 1), cB + hstep + kstep, voffB);
        PG8_WAIT_V(6); PG8_BAR;
    } else {
        PG8_STAGE(PG8_SB(0, 0), cB, voffB); PG8_STAGE(PG8_SA(0, 0), cA, voffA); PG8_STAGE(PG8_SB(0, 1), cB + hstep, voffB); PG8_STAGE(PG8_SA(0, 1), cA + hstep, voffA);
        if (wr == 1) PG8_BAR;
        PG8_WAIT_V(4); PG8_BAR;
        PG8_STAGE(PG8_SB(1, 0), cB + kstep, voffB); PG8_STAGE(PG8_SA(1, 0), cA + kstep, voffA); PG8_STAGE(PG8_SB(1, 1), cB + hstep + kstep, voffB);
        PG8_WAIT_V(6); PG8_BAR;
    }
    for (;;) {
        const bool has_next = S.next(ui + 1, nxt);
        const char* nA = has_next ? (const char*)g.A + (size_t)nxt.pm * tstep : cA; const char* nB = has_next ? (const char*)g.Bt + (size_t)nxt.pn * tstep : cB;
        for (int t = 0; t < nt; t += 2) {
            const bool last = (t == nt - 2);
            if constexpr (Epi::MID) { if (t == (nt >> 1)) { int t2 = lane_id_v(); asm volatile("" : "+v"(t2)); E.mid(acc, cur, wr, wc, t2 & 15, (t2 >> 4) & 3); } }
            const char* a1 = cA + (size_t)(t + 1) * kstep;
            const char* a2 = last ? nA : cA + (size_t)(t + 2) * kstep; const char* b2 = last ? nB : cB + (size_t)(t + 2) * kstep;
            const char* a3 = a2 + kstep; const char* b3 = b2 + kstep;
            if constexpr (SP2) {
            PG8_LDB(B0, 0, 0); PG8_LDB(B1, 0, 1); PG8_SCHED; PG8_LDA(At, 0, 0); PG8_STAGE(PG8_SA(1, 1), a1 + hstep, voffA);
            PG8_WAIT_V(8); PG8_WAIT_L(0); PG8_BAR; PG8_MMA(0, 0, At, B0); PG8_MMA(0, 1, At, B1); PG8_BAR; PG8_SCHED;
            PG8_LDA(At, 0, 1); PG8_STAGE(PG8_SB(0, 0), b2, voffB); PG8_STAGE(PG8_SB(0, 1), b2 + hstep, voffB); PG8_STAGE(PG8_SA(0, 0), a2, voffA);
            PG8_WAIT_V(8); PG8_WAIT_L(0); PG8_BAR; PG8_MMA(1, 0, At, B0); PG8_MMA(1, 1, At, B1); PG8_BAR; PG8_SCHED;
            PG8_LDB(B0, 1, 0); PG8_LDB(B1, 1, 1); PG8_SCHED; PG8_LDA(At, 1, 0); PG8_STAGE(PG8_SA(0, 1), a2 + hstep, voffA);
            PG8_WAIT_V(8); PG8_WAIT_L(0); PG8_BAR; PG8_MMA(0, 0, At, B0); PG8_MMA(0, 1, At, B1); PG8_BAR; PG8_SCHED;
            PG8_LDA(At, 1, 1); PG8_STAGE(PG8_SB(1, 0), b3, voffB); PG8_STAGE(PG8_SB(1, 1), b3 + hstep, voffB); PG8_STAGE(PG8_SA(1, 0), a3, voffA);
            PG8_WAIT_V(8); PG8_WAIT_L(0); PG8_BAR; PG8_MMA(1, 0, At, B0); PG8_MMA(1, 1, At, B1); PG8_BAR; PG8_SCHED;
            } else {
            PG8_LDB(B0, 0, 0); PG8_SCHED; PG8_LDA(At, 0, 0); PG8_STAGE(PG8_SA(1, 1), a1 + hstep, voffA);
            PG8_WAIT_L(8); PG8_BAR; PG8_WAIT_L(0); PG8_MMA(0, 0, At, B0); PG8_BAR; PG8_SCHED;
            PG8_LDB(B1, 0, 1); PG8_STAGE(PG8_SB(0, 0), b2, voffB);
            PG8_BAR; PG8_WAIT_L(0); PG8_MMA(0, 1, At, B1); PG8_BAR;
            PG8_LDA(At, 0, 1); PG8_STAGE(PG8_SA(0, 0), a2, voffA);
            PG8_BAR; PG8_WAIT_L(0); PG8_MMA(1, 0, At, B0); PG8_BAR; PG8_SCHED;
            PG8_STAGE(PG8_SB(0, 1), b2 + hstep, voffB);
            PG8_WAIT_V(6); PG8_BAR; PG8_MMA(1, 1, At, B1); PG8_BAR;
            PG8_LDB(B0, 1, 0); PG8_SCHED; PG8_LDA(At, 1, 0); PG8_STAGE(PG8_SA(0, 1), a2 + hstep, voffA);
            PG8_WAIT_L(8); PG8_BAR; PG8_WAIT_L(0); PG8_MMA(0, 0, At, B0); PG8_BAR; PG8_SCHED;
            PG8_LDB(B1, 1, 1); PG8_STAGE(PG8_SB(1, 0), b3, voffB);
            PG8_BAR; PG8_WAIT_L(0); PG8_MMA(0, 1, At, B1); PG8_BAR;
            PG8_LDA(At, 1, 1); PG8_STAGE(PG8_SA(1, 0), a3, voffA);
            PG8_BAR; PG8_WAIT_L(0); PG8_MMA(1, 0, At, B0); PG8_BAR; PG8_SCHED;
            PG8_STAGE(PG8_SB(1, 1), b3 + hstep, voffB);
            PG8_WAIT_V(6); PG8_BAR; PG8_MMA(1, 1, At, B1); PG8_BAR;
            }
        }
        if constexpr (ALIGN_EPI) { if (wr == 0) PG8_BAR; }
        { int t2 = lane_id_v(); asm volatile("" : "+v"(t2)); E(acc, cur, wr, wc, t2 & 15, (t2 >> 4) & 3); }
        if (!has_next) break;
#pragma unroll
        for (int a = 0; a < 2; ++a)
#pragma unroll
            for (int b = 0; b < 2; ++b)
#pragma unroll
                for (int m = 0; m < 4; ++m)
#pragma unroll
                    for (int n = 0; n < 2; ++n) acc[a][b][m][n] = (f32x4){0.f, 0.f, 0.f, 0.f};
        cur = nxt; cA = nA; cB = nB; ++ui;
        if constexpr (ALIGN_EPI) { if (wr == 1) PG8_BAR; }
    }
    PG8_WAIT_V(0);
    if constexpr (!ALIGN_EPI) { if (wr == 0) PG8_BAR; }
    PG8_BAR;
#undef PG8_SA
#undef PG8_SB
#undef PG8_STAGE
#undef PG8_LDA
#undef PG8_LDB
#undef PG8_MMA
#undef PG8_WAIT_V
#undef PG8_WAIT_L
#undef PG8_BAR
#undef PG8_SCHED
}
}

using pg8::bf16_t; using pg8::bf16x8; using pg8::f32x4; using pg8::u32x4; using pg8::u32x2; using pg8::Unit; using pg8::cvt_pk_bf16;
typedef float f32x16 __attribute__((ext_vector_type(16)));
#define LAS __attribute__((address_space(3)))

constexpr int T_TOK = 32768, SEQ = 4096, DM = 1024, NBATCH = 8, DEPTH = 4, DFF = 4096;
constexpr int IN_COLS = 1984, IN_PAD = 2048;
constexpr float ALPHA = 1.6817928305074290f;
constexpr float LN_EPS = 1e-5f, RMS_EPS = 1e-6f;
constexpr float LOG2E = 1.4426950408889634f;
constexpr float QSCALE_A = 0.125f * LOG2E;
constexpr float QSCALE_M = 0.07216878364870322f * LOG2E;

constexpr size_t MiB = 1u << 20;
constexpr size_t WS_CTL = 0, CTL_ZERO_BYTES = 64 * 1024;
constexpr size_t WS_ROPE = 1 * MiB;
constexpr size_t WS_PCQ = 2 * MiB;
constexpr size_t WS_PCKV = 2 * MiB + 512 * 1024;
constexpr size_t WS_SSA = 3 * MiB;
constexpr size_t WS_SSB = 4 * MiB;
constexpr size_t WS_LSE = 5 * MiB;
constexpr size_t WS_RSQ = 7 * MiB, WS_RSKV = 7 * MiB + 128 * 1024, WS_RSR = 7 * MiB + 256 * 1024, WS_RSB = 7 * MiB + 384 * 1024;
constexpr size_t WS_MU1 = 7 * MiB + 512 * 1024, WS_RS1 = 7 * MiB + 640 * 1024, WS_MU2 = 7 * MiB + 768 * 1024, WS_RS2 = 7 * MiB + 896 * 1024;
constexpr size_t WS_W = 8 * MiB;
constexpr size_t WS_ZB = 32 * MiB;
constexpr size_t WO_IN = 0, WO_UQ = 4 * MiB, WO_UKV = 4 * MiB + 512 * 1024, WO_O = 5 * MiB, WO_1 = 7 * MiB, WO_2 = 15 * MiB;
constexpr size_t WS_XB = 100 * MiB;
constexpr size_t WS_QA = 164 * MiB, WS_KA = 196 * MiB, WS_VA = 228 * MiB, WS_CQ = 260 * MiB, WS_CKV = 276 * MiB;
constexpr size_t WS_QM = 284 * MiB, WS_KM = 332 * MiB, WS_VM = 380 * MiB, WS_AO = 412 * MiB, WS_END = 476 * MiB;
constexpr size_t WS_HF = 164 * MiB;

constexpr int LDS_BYTES = 147456;

typedef float f32x2_t __attribute__((ext_vector_type(2))); typedef __bf16 bf16x2_t __attribute__((ext_vector_type(2)));
__device__ __forceinline__ unsigned cvtpk(float lo, float hi) { f32x2_t v = {lo, hi}; bf16x2_t b = __builtin_convertvector(v, bf16x2_t); return __builtin_bit_cast(unsigned, b); }
__device__ __forceinline__ float bf_lo(unsigned u) { return __uint_as_float(u << 16); }
__device__ __forceinline__ float bf_hi(unsigned u) { return __uint_as_float(u & 0xffff0000u); }
__device__ __forceinline__ void st_bf16x4(bf16_t* p, f32x4 v) { u32x2 w; w.x = cvtpk(v[0], v[1]); w.y = cvtpk(v[2], v[3]); *(u32x2*)p = w; }
template <int XM> __device__ __forceinline__ float swz_xor(float v) { return __int_as_float(__builtin_amdgcn_ds_swizzle(__float_as_int(v), (XM << 10) | 0x1f)); }
__device__ __forceinline__ float xadd32(float v) { auto rr = __builtin_amdgcn_permlane32_swap(__float_as_uint(v), __float_as_uint(v), false, false); return __uint_as_float(rr[0]) + __uint_as_float(rr[1]); }
__device__ __forceinline__ float xmax32(float v) { auto rr = __builtin_amdgcn_permlane32_swap(__float_as_uint(v), __float_as_uint(v), false, false); return fmaxf(__uint_as_float(rr[0]), __uint_as_float(rr[1])); }
__device__ __forceinline__ float wave_sum(float v) {
    v += swz_xor<1>(v); v += swz_xor<2>(v); v += swz_xor<4>(v); v += swz_xor<8>(v); v += swz_xor<16>(v);
    return xadd32(v);
}
__device__ __forceinline__ int lane_id() { return lane_id_v(); }
__device__ __forceinline__ int crow(int r, int hi) { return (r & 3) + 8 * (r >> 2) + 4 * hi; }

__device__ __forceinline__ void st_bf16x8(bf16_t* p, f32x4 a, f32x4 b) { u32x4 w; w.x = cvtpk(a[0], a[1]); w.y = cvtpk(a[2], a[3]); w.z = cvtpk(b[0], b[1]); w.w = cvtpk(b[2], b[3]); *(u32x4*)p = w; }
__device__ __forceinline__ float sumsq8(f32x4 a, f32x4 b) { return ((a[0] * a[0] + a[1] * a[1]) + (a[2] * a[2] + a[3] * a[3])) + ((b[0] * b[0] + b[1] * b[1]) + (b[2] * b[2] + b[3] * b[3])); }
struct EpiIn {
    static constexpr bool PERM = true, MID = false;
    bf16_t *QA, *KA, *VA, *CQ, *CKV, *KM; float *pcq, *pckv; const float* cs;
    __device__ __forceinline__ void operator()(const f32x4 (&acc)[2][2][4][2], const Unit& u, int wr, int wc, int fr, int fq) const {
        const int pn = u.pn; const int row0 = u.pm * 256 + wr * 64 + fr;
        if (pn < 4) {
            bf16_t* base = (pn < 2) ? QA : KA; const float sc = (pn < 2) ? QSCALE_A : 1.f;
#pragma unroll
            for (int ai = 0; ai < 2; ++ai) {
                f32x4 cv[4][4];
#pragma unroll
                for (int m = 0; m < 4; ++m) { const int pos = (row0 + ai * 128 + m * 16) & (SEQ - 1); const float* cp = cs + pos * 32 + 8 * fq;
                    cv[m][0] = *(const f32x4*)cp; cv[m][1] = *(const f32x4*)(cp + 4); cv[m][2] = *(const f32x4*)(cp + SEQ * 32); cv[m][3] = *(const f32x4*)(cp + SEQ * 32 + 4); }
#pragma unroll
                for (int m = 0; m < 4; ++m) {
                    const int row = row0 + ai * 128 + m * 16;
                    const f32x4 c0 = cv[m][0] * sc, c1 = cv[m][1] * sc, s0 = cv[m][2] * sc, s1 = cv[m][3] * sc;
                    const f32x4 xa0 = acc[ai][0][m][0], xa1 = acc[ai][0][m][1], xb0 = acc[ai][1][m][0], xb1 = acc[ai][1][m][1];
                    bf16_t* p = base + (unsigned)(row * 512 + 256 * (pn & 1) + 64 * wc + 8 * fq);
                    st_bf16x8(p, xa0 * c0 - xb0 * s0, xa1 * c1 - xb1 * s1); st_bf16x8(p + 32, xb0 * c0 + xa0 * s0, xb1 * c1 + xa1 * s1);
                }
                asm volatile("" ::: "memory");
            }
        } else if (pn < 7) {
            bf16_t* dst = (pn < 6) ? VA : CQ; const int ld = (pn < 6) ? 512 : 256; const int cb = (pn == 5) ? 256 : 0;
#pragma unroll
            for (int ai = 0; ai < 2; ++ai)
#pragma unroll
                for (int m = 0; m < 4; ++m) {
                    const int row = row0 + ai * 128 + m * 16; float ss = 0.f;
#pragma unroll
                    for (int bj = 0; bj < 2; ++bj) { ss += sumsq8(acc[ai][bj][m][0], acc[ai][bj][m][1]);
                        st_bf16x8(dst + (unsigned)(row * ld + cb + 128 * bj + 32 * wc + 8 * fq), acc[ai][bj][m][0], acc[ai][bj][m][1]); }
                    if (pn == 6) { ss += swz_xor<16>(ss); ss = xadd32(ss); if (fq == 0) pcq[row * 4 + wc] = ss; }
                }
        } else {
#pragma unroll
            for (int ai = 0; ai < 2; ++ai)
#pragma unroll
                for (int m = 0; m < 4; ++m) {
                    const int row = row0 + ai * 128 + m * 16; float ss = 0.f;
                    if (wc < 3) { ss += sumsq8(acc[ai][0][m][0], acc[ai][0][m][1]); st_bf16x8(CKV + (unsigned)(row * 128 + 32 * wc + 8 * fq), acc[ai][0][m][0], acc[ai][0][m][1]); }
                    if (wc == 0) { ss += sumsq8(acc[ai][1][m][0], acc[ai][1][m][1]); st_bf16x8(CKV + (unsigned)(row * 128 + 96 + 8 * fq), acc[ai][1][m][0], acc[ai][1][m][1]); }
                    ss += swz_xor<16>(ss); ss = xadd32(ss); if (fq == 0) pckv[row * 4 + wc] = ss;
                    if (wc == 3) {
                        const int pos = row & (SEQ - 1); const float* cp = cs + pos * 32 + 8 * fq;
                        const f32x4 c0 = *(const f32x4*)cp, c1 = *(const f32x4*)(cp + 4), s0 = *(const f32x4*)(cp + SEQ * 32), s1 = *(const f32x4*)(cp + SEQ * 32 + 4);
                        const f32x4 xa0 = acc[ai][0][m][0], xa1 = acc[ai][0][m][1], xb0 = acc[ai][1][m][0], xb1 = acc[ai][1][m][1];
                        const f32x4 o10 = xa0 * c0 - xb0 * s0, o11 = xa1 * c1 - xb1 * s1, o20 = xb0 * c0 + xa0 * s0, o21 = xb1 * c1 + xa1 * s1;
#pragma unroll
                        for (int h = 0; h < 4; ++h) { bf16_t* p = KM + (unsigned)(row * 768 + h * 192 + 128 + 8 * fq); st_bf16x8(p, o10, o11); st_bf16x8(p + 32, o20, o21); }
                    }
                }
        }
    }
};

struct EpiUpQ {
    static constexpr bool PERM = true, MID = false;
    bf16_t* QM; const float* rsq; const float* cs;
    __device__ __forceinline__ void operator()(const f32x4 (&acc)[2][2][4][2], const Unit& u, int wr, int wc, int fr, int fq) const {
        const int pn = u.pn; const int row0 = u.pm * 256 + wr * 64 + fr;
#pragma unroll
        for (int ai = 0; ai < 2; ++ai)
#pragma unroll
            for (int m = 0; m < 4; ++m) {
                const int row = row0 + ai * 128 + m * 16;
                const float rs = rsq[row];
                if (pn < 2) {
#pragma unroll
                    for (int bj = 0; bj < 2; ++bj)
                        st_bf16x8(QM + (unsigned)(row * 768 + (2 * pn + bj) * 192 + 32 * wc + 8 * fq), acc[ai][bj][m][0] * rs, acc[ai][bj][m][1] * rs);
                } else {
                    const int pos = row & (SEQ - 1); const float* cp = cs + pos * 32 + 8 * fq;
                    const f32x4 c0 = *(const f32x4*)cp * rs, c1 = *(const f32x4*)(cp + 4) * rs, s0 = *(const f32x4*)(cp + SEQ * 32) * rs, s1 = *(const f32x4*)(cp + SEQ * 32 + 4) * rs;
                    const f32x4 xa0 = acc[ai][0][m][0], xa1 = acc[ai][0][m][1], xb0 = acc[ai][1][m][0], xb1 = acc[ai][1][m][1];
                    bf16_t* p = QM + (unsigned)(row * 768 + wc * 192 + 128 + 8 * fq);
                    st_bf16x8(p, xa0 * c0 - xb0 * s0, xa1 * c1 - xb1 * s1); st_bf16x8(p + 32, xb0 * c0 + xa0 * s0, xb1 * c1 + xa1 * s1);
                }
                if (m & 1) asm volatile("" ::: "memory");
            }
    }
};

struct EpiUpKV {
    static constexpr bool PERM = true, MID = false;
    bf16_t *KM, *VM; const float* rskv;
    __device__ __forceinline__ void operator()(const f32x4 (&acc)[2][2][4][2], const Unit& u, int wr, int wc, int fr, int fq) const {
        const int pn = u.pn; const int row0 = u.pm * 256 + wr * 64 + fr;
#pragma unroll
        for (int ai = 0; ai < 2; ++ai)
#pragma unroll
            for (int m = 0; m < 4; ++m) {
                const int row = row0 + ai * 128 + m * 16;
                const float rs = rskv[row];
                st_bf16x8(KM + (unsigned)(row * 768 + pn * 192 + 32 * wc + 8 * fq), acc[ai][0][m][0] * rs, acc[ai][0][m][1] * rs);
                st_bf16x8(VM + (unsigned)(row * 512 + pn * 128 + 32 * wc + 8 * fq), acc[ai][1][m][0] * rs, acc[ai][1][m][1] * rs);
                if (m & 1) asm volatile("" ::: "memory");
            }
    }
};

constexpr int LDS_GB_OFF = 131072 + 1024;
struct ResLn { const float* x32; const bf16_t* zb; const float* mu; const float* rs; int ln; };
__device__ __forceinline__ void ld8_bf16(const bf16_t* p, f32x4& a, f32x4& b) { const u32x4 w = *(const u32x4*)p; a = (f32x4){bf_lo(w.x), bf_hi(w.x), bf_lo(w.y), bf_hi(w.y)}; b = (f32x4){bf_lo(w.z), bf_hi(w.z), bf_lo(w.w), bf_hi(w.w)}; }
__device__ __forceinline__ void resid_epilogue(const f32x4 (&acc)[2][2][4][2], const ResLn& R, bf16_t* zout, const float* rsb, LAS const unsigned char* lds_gb, const Unit& u, int wr, int wc, int fr, int fq) {
    const int row0 = u.pm * 256 + wr * 64 + fr; const int col0 = u.pn * 256 + 32 * wc + 8 * fq;
    if (R.ln) {
#pragma unroll
        for (int ai = 0; ai < 2; ++ai) {
            u32x4 zr[4][2]; float mu[4], rs[4], rb[4];
#pragma unroll
            for (int m = 0; m < 4; ++m) { const int row = row0 + ai * 128 + m * 16; rb[m] = rsb ? rsb[row] : 1.f; mu[m] = R.mu[row]; rs[m] = R.rs[row];
                zr[m][0] = *(const u32x4*)(R.zb + (unsigned)(row * DM + col0)); zr[m][1] = *(const u32x4*)(R.zb + (unsigned)(row * DM + col0 + 128)); }
#pragma unroll
            for (int bj = 0; bj < 2; ++bj) {
                const int col = col0 + 128 * bj;
                const f32x4 g0 = *(const LAS f32x4*)(lds_gb + col * 4), g1 = *(const LAS f32x4*)(lds_gb + col * 4 + 16), b0 = *(const LAS f32x4*)(lds_gb + 4096 + col * 4), b1 = *(const LAS f32x4*)(lds_gb + 4096 + col * 4 + 16);
#pragma unroll
                for (int m = 0; m < 4; ++m) { const int row = row0 + ai * 128 + m * 16; const u32x4 w = zr[m][bj];
                    const f32x4 z0 = {bf_lo(w.x), bf_hi(w.x), bf_lo(w.y), bf_hi(w.y)}, z1 = {bf_lo(w.z), bf_hi(w.z), bf_lo(w.w), bf_hi(w.w)};
                    const f32x4 x0 = (z0 - mu[m]) * rs[m] * g0 + b0, x1 = (z1 - mu[m]) * rs[m] * g1 + b1;
                    st_bf16x8(zout + (unsigned)(row * DM + col), x0 * ALPHA + acc[ai][bj][m][0] * rb[m], x1 * ALPHA + acc[ai][bj][m][1] * rb[m]); }
            }
            asm volatile("" ::: "memory");
        }
    } else {
#pragma unroll
        for (int ai = 0; ai < 2; ++ai) {
            f32x4 xr[4][2][2]; float rb[4];
#pragma unroll
            for (int m = 0; m < 4; ++m) { const int row = row0 + ai * 128 + m * 16; rb[m] = rsb ? rsb[row] : 1.f;
#pragma unroll
                for (int bj = 0; bj < 2; ++bj) { const float* p = R.x32 + (unsigned)(row * DM + col0 + 128 * bj); xr[m][bj][0] = *(const f32x4*)p; xr[m][bj][1] = *(const f32x4*)(p + 4); } }
#pragma unroll
            for (int m = 0; m < 4; ++m) { const int row = row0 + ai * 128 + m * 16;
#pragma unroll
                for (int bj = 0; bj < 2; ++bj)
                    st_bf16x8(zout + (unsigned)(row * DM + col0 + 128 * bj), xr[m][bj][0] * ALPHA + acc[ai][bj][m][0] * rb[m], xr[m][bj][1] * ALPHA + acc[ai][bj][m][1] * rb[m]); }
            asm volatile("" ::: "memory");
        }
    }
}
struct EpiOut {
    static constexpr bool PERM = true, MID = true;
    ResLn R; bf16_t* out; const float *rsr, *rsb; LAS const unsigned char* lds_gb;
    __device__ __forceinline__ void mid(f32x4 (&acc)[2][2][4][2], const Unit& u, int wr, int wc, int fr, int fq) const {
        const int row0 = u.pm * 256 + wr * 64 + fr;
#pragma unroll
        for (int ai = 0; ai < 2; ++ai)
#pragma unroll
            for (int m = 0; m < 4; ++m) { const float ratio = rsr[row0 + ai * 128 + m * 16];
#pragma unroll
                for (int bj = 0; bj < 2; ++bj)
#pragma unroll
                    for (int n = 0; n < 2; ++n) acc[ai][bj][m][n] *= ratio; }
    }
    __device__ __forceinline__ void operator()(const f32x4 (&acc)[2][2][4][2], const Unit& u, int wr, int wc, int fr, int fq) const {
        resid_epilogue(acc, R, out, rsb, lds_gb, u, wr, wc, fr, fq);
    }
};

struct EpiFfn1 {
    static constexpr bool PERM = true, MID = false;
    bf16_t* O;
    __device__ __forceinline__ void operator()(const f32x4 (&acc)[2][2][4][2], const Unit& u, int wr, int wc, int fr, int fq) const {
        const int row0 = u.pm * 256 + wr * 64 + fr; const int col0 = u.pn * 256 + wc * 32 + 8 * fq;
#pragma unroll
        for (int ai = 0; ai < 2; ++ai)
#pragma unroll
            for (int m = 0; m < 4; ++m) { bf16_t* rowp = O + (unsigned)((row0 + ai * 128 + m * 16) * DFF + col0);
#pragma unroll
                for (int bj = 0; bj < 2; ++bj) { f32x4 v0 = acc[ai][bj][m][0], v1 = acc[ai][bj][m][1];
#pragma unroll
                    for (int e = 0; e < 4; ++e) { const float a = fmaxf(v0[e], 0.f), b = fmaxf(v1[e], 0.f); v0[e] = a * a; v1[e] = b * b; }
                    u32x4 w; w.x = cvtpk(v0[0], v0[1]); w.y = cvtpk(v0[2], v0[3]); w.z = cvtpk(v1[0], v1[1]); w.w = cvtpk(v1[2], v1[3]);
                    *(u32x4*)(rowp + bj * 128) = w; } }
    }
};

struct EpiFfn2 {
    static constexpr bool PERM = true, MID = false;
    ResLn R; bf16_t* X; LAS const unsigned char* lds_gb;
    __device__ __forceinline__ void operator()(const f32x4 (&acc)[2][2][4][2], const Unit& u, int wr, int wc, int fr, int fq) const {
        resid_epilogue(acc, R, X, nullptr, lds_gb, u, wr, wc, fr, fq);
    }
};

__device__ __forceinline__ unsigned f2bf(float f) { unsigned u = __builtin_bit_cast(unsigned, f); return (u + 0x7fffu + ((u >> 16) & 1u)) >> 16; }
__device__ __forceinline__ unsigned pk2(float lo, float hi) { return f2bf(lo) | (f2bf(hi) << 16); }

__device__ __forceinline__ int map_in(int np) {
    const int pn = np >> 8, cc = np & 255, bj = cc >> 7, wc = (cc >> 5) & 3, r = cc & 31;
    if (pn < 4) return 256 * pn + 64 * wc + 32 * bj + r;
    if (pn < 7) return np;
    if (bj == 0) return (wc < 3) ? 1792 + 32 * wc + r : 1920 + r;
    return (wc == 0) ? 1792 + 96 + r : (wc == 3) ? 1920 + 32 + r : -1;
}
__device__ __forceinline__ int map_uq(int np) {
    const int pn = np >> 8, cc = np & 255, bj = cc >> 7, wc = (cc >> 5) & 3, r = cc & 31;
    if (pn < 2) return (2 * pn + bj) * 192 + (cc & 127);
    return wc * 192 + 128 + 32 * bj + r;
}
template <int MAP>
__device__ __forceinline__ void conv_item(const float* __restrict__ W, int K, int N, bf16_t* __restrict__ WT, const float* __restrict__ g0, const float* __restrict__ g1, int ksplit, int nb, int kb, int lane) {
    const int np = 64 * nb + lane, k0 = 64 * kb;
    const int src = (MAP == 1) ? map_in(np) : (MAP == 2) ? map_uq(np) : np;
    const float* wp = W + (size_t)k0 * N + (src >= 0 ? src : 0);
    bf16_t* op = WT + (size_t)np * K + k0;
#pragma unroll
    for (int h = 0; h < 2; ++h) {
        float v[32];
#pragma unroll
        for (int j = 0; j < 32; ++j) v[j] = wp[(size_t)(32 * h + j) * N];
        if (g0) {
#pragma unroll
            for (int j = 0; j < 32; ++j) { const int kx = k0 + 32 * h + j; v[j] *= (kx < ksplit) ? g0[kx] : g1[kx - ksplit]; }
        }
        if (src < 0) {
#pragma unroll
            for (int j = 0; j < 32; ++j) v[j] = 0.f;
        }
#pragma unroll
        for (int c = 0; c < 4; ++c) { u32x4 o; o.x = cvtpk(v[8 * c], v[8 * c + 1]); o.y = cvtpk(v[8 * c + 2], v[8 * c + 3]); o.z = cvtpk(v[8 * c + 4], v[8 * c + 5]); o.w = cvtpk(v[8 * c + 6], v[8 * c + 7]);
            *(u32x4*)(op + 32 * h + 8 * c) = o; }
    }
}

template <bool LITE>
__device__ __forceinline__ void ln_rows(const bf16_t* ZB, float* OUT32, bf16_t* XB, float* MU, float* RS, const float* g, const float* bt, int NGW, int wv) {
    int tid_o = wv * 64 + lane_id(); asm volatile("" : "+v"(tid_o));
    const int lane = tid_o & 63; const int gw = blockIdx.x * 8 + __builtin_amdgcn_readfirstlane(tid_o >> 6);
    const f32x4 g0 = ((const f32x4*)g)[lane], g1 = ((const f32x4*)g)[lane + 64], g2 = ((const f32x4*)g)[lane + 128], g3 = ((const f32x4*)g)[lane + 192];
    const f32x4 b0 = ((const f32x4*)bt)[lane], b1 = ((const f32x4*)bt)[lane + 64], b2 = ((const f32x4*)bt)[lane + 128], b3 = ((const f32x4*)bt)[lane + 192];
    for (int rowb = gw; rowb < T_TOK; rowb += 4 * NGW) {
        u32x2 zr[4][4];
#pragma unroll
        for (int q = 0; q < 4; ++q) { const int row = rowb + q * NGW; if (row < T_TOK) { const u32x2* xr = (const u32x2*)(ZB + (size_t)row * DM) + lane;
#pragma unroll
            for (int j = 0; j < 4; ++j) zr[q][j] = xr[64 * j]; } }
#pragma unroll
        for (int q = 0; q < 4; ++q) { const int row = rowb + q * NGW; if (row < T_TOK) {
            f32x4 v[4]; float s = 0.f;
#pragma unroll
            for (int j = 0; j < 4; ++j) { v[j] = (f32x4){bf_lo(zr[q][j].x), bf_hi(zr[q][j].x), bf_lo(zr[q][j].y), bf_hi(zr[q][j].y)}; s += (v[j][0] + v[j][1]) + (v[j][2] + v[j][3]); }
            const float mean = wave_sum(s) * (1.f / DM); float s2 = 0.f;
#pragma unroll
            for (int j = 0; j < 4; ++j) { v[j] = v[j] - mean; s2 += (v[j][0] * v[j][0] + v[j][1] * v[j][1]) + (v[j][2] * v[j][2] + v[j][3] * v[j][3]); }
            const float rstd = 1.f / sqrtf(wave_sum(s2) * (1.f / DM) + LN_EPS);
            v[0] = v[0] * rstd * g0 + b0; v[1] = v[1] * rstd * g1 + b1; v[2] = v[2] * rstd * g2 + b2; v[3] = v[3] * rstd * g3 + b3;
            if constexpr (LITE) {
                u32x2* o8 = (u32x2*)(XB + (size_t)row * DM) + lane;
#pragma unroll
                for (int j = 0; j < 4; ++j) { u32x2 w; w.x = cvtpk(v[j][0], v[j][1]); w.y = cvtpk(v[j][2], v[j][3]); o8[64 * j] = w; }
                if (lane == 0) { MU[row] = mean; RS[row] = rstd; }
            } else {
                f32x4* xr = (f32x4*)(OUT32 + (size_t)row * DM) + lane;
#pragma unroll
                for (int j = 0; j < 4; ++j) xr[64 * j] = v[j];
            }
        } }
    }
}

#define MFMA32(a, b, c) __builtin_amdgcn_mfma_f32_32x32x16_bf16((a), (b), (c), 0, 0, 0)
constexpr int MLA_KP = 400, MLA_VP = 136, MLA_KBUF = 64 * MLA_KP, MLA_VBUF = 128 * MLA_VP;
__device__ __forceinline__ void mla_unit(LAS char* shm, const bf16_t* __restrict__ QM, const bf16_t* __restrict__ KM, const bf16_t* __restrict__ VM, bf16_t* AO, float* ssB, int b, int h, int qb, int wv) {
    int tid_o = wv * 64 + lane_id(); asm volatile("" : "+v"(tid_o));
    const int tid = tid_o, lane = tid & 63, wid = __builtin_amdgcn_readfirstlane(tid >> 6), r32 = lane & 31, hi = lane >> 5;
    const size_t rowbase = (size_t)b * SEQ; const int q0 = qb * 256; const int NT = (q0 + 256) / 64;
    const int qw = q0 + wid * 32;
    bf16x8 qf[12];
    { const bf16_t* qp = QM + (rowbase + qw + r32) * 768 + h * 192 + hi * 8;
#pragma unroll
      for (int ks = 0; ks < 12; ++ks) qf[ks] = *(const bf16x8*)(qp + ks * 16); }
    int kkey[3], kch[3];
#pragma unroll
    for (int i = 0; i < 3; ++i) { const int id = tid + 512 * i; kkey[i] = id / 24; kch[i] = id % 24; }
    const int vc = 4 * (wid & 3) + (lane & 3), vkp = 16 * (wid >> 2) + (lane >> 2);
    const bf16_t* kg = KM + rowbase * 768 + h * 192; const bf16_t* vg = VM + rowbase * 512 + h * 128 + vc * 8;
    u32x4 kreg[3], vreg[2];
#define MLA_ISSUE(t) do { _Pragma("unroll") for (int i = 0; i < 3; ++i) kreg[i] = *(const u32x4*)(kg + (size_t)((t) * 64 + kkey[i]) * 768 + kch[i] * 8); \
        vreg[0] = *(const u32x4*)(vg + (size_t)((t) * 64 + 2 * vkp) * 512); vreg[1] = *(const u32x4*)(vg + (size_t)((t) * 64 + 2 * vkp + 1) * 512); } while (0)
#define MLA_WRITE(buf) do { LAS char* kb_ = shm + (buf) * MLA_KBUF; _Pragma("unroll") for (int i = 0; i < 3; ++i) *(LAS u32x4*)(kb_ + kkey[i] * MLA_KP + kch[i] * 16) = kreg[i]; \
        LAS char* vb_ = shm + 2 * MLA_KBUF + (buf) * MLA_VBUF + (8 * vc) * MLA_VP + 4 * vkp; \
        _Pragma("unroll") for (int j = 0; j < 4; ++j) { const unsigned a_ = vreg[0][j], b_ = vreg[1][j]; \
            *(LAS unsigned*)(vb_ + (2 * j) * MLA_VP) = (a_ & 0xffffu) | (b_ << 16); *(LAS unsigned*)(vb_ + (2 * j + 1) * MLA_VP) = (a_ >> 16) | (b_ & 0xffff0000u); } } while (0)
    f32x16 o[4];
#pragma unroll
    for (int d = 0; d < 4; ++d) o[d] = f32x16{};
    float mrun = -1e30f, lrun = 0.f;
    MLA_ISSUE(0); MLA_WRITE(0); __syncthreads();
    for (int t = 0; t < NT; ++t) {
        const int cur = t & 1;
        if (t + 1 < NT) MLA_ISSUE(t + 1);
        if (t * 64 <= qw + 31) {
            f32x16 s0 = f32x16{}, s1 = f32x16{};
            { const LAS char* kb = shm + cur * MLA_KBUF + r32 * MLA_KP + hi * 16;
              bf16x8 ka[2][6];
#pragma unroll
              for (int i = 0; i < 3; ++i) { ka[0][2 * i] = *(const LAS bf16x8*)(kb + i * 32); ka[0][2 * i + 1] = *(const LAS bf16x8*)(kb + 32 * MLA_KP + i * 32); }
              __builtin_amdgcn_sched_barrier(0);
#pragma unroll
              for (int bt = 0; bt < 4; ++bt) {
                  if (bt < 3) {
#pragma unroll
                      for (int i = 0; i < 3; ++i) { ka[(bt + 1) & 1][2 * i] = *(const LAS bf16x8*)(kb + (3 * (bt + 1) + i) * 32); ka[(bt + 1) & 1][2 * i + 1] = *(const LAS bf16x8*)(kb + 32 * MLA_KP + (3 * (bt + 1) + i) * 32); }
                  }
                  __builtin_amdgcn_sched_barrier(0);
#pragma unroll
                  for (int i = 0; i < 3; ++i) { s0 = MFMA32(ka[bt & 1][2 * i], qf[3 * bt + i], s0); s1 = MFMA32(ka[bt & 1][2 * i + 1], qf[3 * bt + i], s1); }
                  __builtin_amdgcn_sched_barrier(0);
              } }
            if (t * 64 + 63 > qw) {
                const int qq = qw + r32;
#pragma unroll
                for (int r = 0; r < 16; ++r) { const int kv = t * 64 + crow(r, hi); if (kv > qq) s0[r] = -INFINITY; if (kv + 32 > qq) s1[r] = -INFINITY; }
            }
            float mx = fmaxf(s0[0], s1[0]);
#pragma unroll
            for (int r = 1; r < 16; ++r) mx = fmaxf(mx, fmaxf(s0[r], s1[r]));
            mx = xmax32(mx);
            const float mnew = fmaxf(mrun, mx); const float alpha = __builtin_amdgcn_exp2f(mrun - mnew); mrun = mnew;
            float ps = 0.f;
#pragma unroll
            for (int r = 0; r < 16; ++r) { s0[r] = __builtin_amdgcn_exp2f(s0[r] - mnew); s1[r] = __builtin_amdgcn_exp2f(s1[r] - mnew); ps += s0[r] + s1[r]; }
            lrun = lrun * alpha + ps;
#pragma unroll
            for (int d = 0; d < 4; ++d) o[d] *= alpha;
            u32x4 pw[4];
#pragma unroll
            for (int j = 0; j < 4; ++j) { pw[0][j] = cvtpk(s0[2 * j], s0[2 * j + 1]); pw[1][j] = cvtpk(s0[8 + 2 * j], s0[9 + 2 * j]); pw[2][j] = cvtpk(s1[2 * j], s1[2 * j + 1]); pw[3][j] = cvtpk(s1[8 + 2 * j], s1[9 + 2 * j]); }
            { const LAS char* vb = shm + 2 * MLA_KBUF + cur * MLA_VBUF + r32 * MLA_VP + hi * 8;
              u32x2 vlo[2][4], vhi[2][4];
#pragma unroll
              for (int d = 0; d < 4; ++d) { vlo[0][d] = *(const LAS u32x2*)(vb + d * 32 * MLA_VP); vhi[0][d] = *(const LAS u32x2*)(vb + d * 32 * MLA_VP + 16); }
              __builtin_amdgcn_sched_barrier(0);
#pragma unroll
              for (int j = 0; j < 4; ++j) {
                  if (j < 3) {
#pragma unroll
                      for (int d = 0; d < 4; ++d) { vlo[(j + 1) & 1][d] = *(const LAS u32x2*)(vb + d * 32 * MLA_VP + (j + 1) * 32); vhi[(j + 1) & 1][d] = *(const LAS u32x2*)(vb + d * 32 * MLA_VP + (j + 1) * 32 + 16); }
                  }
                  __builtin_amdgcn_sched_barrier(0);
#pragma unroll
                  for (int d = 0; d < 4; ++d) { const u32x4 va = {vlo[j & 1][d].x, vlo[j & 1][d].y, vhi[j & 1][d].x, vhi[j & 1][d].y};
                      o[d] = MFMA32(__builtin_bit_cast(bf16x8, va), __builtin_bit_cast(bf16x8, pw[j]), o[d]); }
                  __builtin_amdgcn_sched_barrier(0);
              } }
        }
        if (t + 1 < NT) MLA_WRITE(cur ^ 1);
        __syncthreads();
    }
#undef MLA_ISSUE
#undef MLA_WRITE
    lrun = xadd32(lrun);
    const float inv = 1.f / lrun; float ss = 0.f;
    const size_t row = rowbase + qw + r32;
    LAS char* ot = shm + wid * 8704;
#pragma unroll
    for (int d = 0; d < 4; ++d)
#pragma unroll
        for (int g = 0; g < 4; ++g) { const f32x4 v = {o[d][4 * g] * inv, o[d][4 * g + 1] * inv, o[d][4 * g + 2] * inv, o[d][4 * g + 3] * inv};
            ss += (v[0] * v[0] + v[1] * v[1]) + (v[2] * v[2] + v[3] * v[3]);
            u32x2 w; w.x = cvtpk(v[0], v[1]); w.y = cvtpk(v[2], v[3]); *(LAS u32x2*)(ot + r32 * 272 + (32 * d + 8 * g + 4 * hi) * 2) = w; }
    ss = xadd32(ss);
    if (hi == 0) ssB[row * 4 + h] = ss;
    asm volatile("s_waitcnt lgkmcnt(0)" ::: "memory");
    { const int rr = lane >> 4, ch = lane & 15;
      bf16_t* ob = AO + (rowbase + qw) * 1024 + 512 + h * 128 + ch * 8;
#pragma unroll
      for (int i = 0; i < 8; ++i) { const int ri = 4 * i + rr; *(u32x4*)(ob + (size_t)ri * 1024) = *(const LAS u32x4*)(ot + ri * 272 + ch * 16); } }
    asm volatile("s_waitcnt lgkmcnt(0)" ::: "memory");
    __syncthreads();
}

constexpr int BD_KP = 144, BD_VP = 776, BD_KBYTES = 384 * BD_KP, BD_VBYTES = 64 * BD_VP;
struct BandUnit { int b, head, d, rho, blk, pidx; };
template <bool FINAL> __device__ __forceinline__ BandUnit band_decode(int u) {
    BandUnit r;
    if constexpr (FINAL) { r.b = u >> 7; r.head = (u >> 4) & 7; r.d = 1; r.rho = 0; r.blk = u & 15; r.pidx = 0; }
    else if (u < 1024) { r.b = u >> 7; r.head = (u >> 4) & 7; r.d = 16; r.rho = u & 15; r.blk = 0; r.pidx = 0; }
    else { const int v = u - 1024; r.b = v >> 7; r.head = (v >> 4) & 7; r.d = 4; r.rho = (v >> 2) & 3; r.blk = v & 3; r.pidx = 1; }
    return r;
}
template <bool FINAL>
__device__ __forceinline__ void band_phase(LAS char* shm, const bf16_t* __restrict__ QA, const bf16_t* __restrict__ KA, const bf16_t* __restrict__ VA,
                                           bf16_t* OP, float* LSE, bf16_t* AO, float* ssA, int first, int nunits, int stride, int wv) {
    int tid_o = wv * 64 + lane_id(); asm volatile("" : "+v"(tid_o));
    const int tid = tid_o, lane = tid & 63, wid = __builtin_amdgcn_readfirstlane(tid >> 6), r32 = lane & 31, hi = lane >> 5;
    const int kk = tid >> 3, c8 = tid & 7;
    u32x4 kreg[6], vreg[3][2];
#define BD_ISSUE(U) do { const unsigned rb_ = (unsigned)(U).b * SEQ + (U).rho; const int p0_ = (U).blk * 256 - 128; const int k0_ = ((U).blk == 0) ? 2 : 0; \
        const bf16_t* kg_ = KA + (unsigned)(rb_ * 512 + (U).head * 64 + c8 * 8); const bf16_t* vg_ = VA + (unsigned)(rb_ * 512 + (U).head * 64 + c8 * 8); \
        _Pragma("unroll") for (int i = 0; i < 6; ++i) if (i >= k0_) kreg[i] = *(const u32x4*)(kg_ + (unsigned)((U).d * (p0_ + 64 * i + kk) * 512)); \
        _Pragma("unroll") for (int i = 0; i < 3; ++i) if (2 * i + 1 >= k0_) { const int kp_ = p0_ + 2 * (kk + 64 * i); \
            vreg[i][0] = *(const u32x4*)(vg_ + (unsigned)((U).d * kp_ * 512)); vreg[i][1] = *(const u32x4*)(vg_ + (unsigned)((U).d * (kp_ + 1) * 512)); } } while (0)
#define BD_WRITE(U) do { const int k0_ = ((U).blk == 0) ? 2 : 0; \
        _Pragma("unroll") for (int i = 0; i < 6; ++i) if (i >= k0_) *(LAS u32x4*)(shm + (64 * i + kk) * BD_KP + c8 * 16) = kreg[i]; \
        _Pragma("unroll") for (int i = 0; i < 3; ++i) if (2 * i + 1 >= k0_) { LAS char* vb_ = shm + BD_KBYTES + (8 * c8) * BD_VP + 4 * (kk + 64 * i); \
            _Pragma("unroll") for (int j = 0; j < 4; ++j) { const unsigned a_ = vreg[i][0][j], b_ = vreg[i][1][j]; \
                *(LAS unsigned*)(vb_ + (2 * j) * BD_VP) = (a_ & 0xffffu) | (b_ << 16); *(LAS unsigned*)(vb_ + (2 * j + 1) * BD_VP) = (a_ >> 16) | (b_ & 0xffff0000u); } } } while (0)
    int u = first; asm volatile("" : "+s"(u));
    BandUnit U = band_decode<FINAL>(u);
    BD_ISSUE(U);
    for (;;) {
        const int b = U.b, head = U.head, d = U.d, rho = U.rho, blk = U.blk, pidx = U.pidx;
        const unsigned rowbase = (unsigned)b * SEQ; const int P0 = blk * 256;
        const unsigned row = rowbase + rho + d * (P0 + wid * 32 + r32);
        bf16x8 qf[4];
        { const bf16_t* qp = QA + (unsigned)(row * 512 + head * 64 + hi * 8);
#pragma unroll
          for (int ks = 0; ks < 4; ++ks) qf[ks] = *(const bf16x8*)(qp + ks * 16); }
        BD_WRITE(U);
        __syncthreads();
        const int un = u + stride; const bool has_next = un < nunits;
        if (has_next) { U = band_decode<FINAL>(un); BD_ISSUE(U); }
        f32x16 o[2]; o[0] = f32x16{}; o[1] = f32x16{};
        float mrun = -1e30f, lrun = 0.f;
        const int k0 = (blk == 0) ? 2 : 0;
#pragma unroll 1
        for (int kap = k0; kap < 6; ++kap) {
            if (64 * kap >= 32 * wid - 63 && 64 * kap <= 32 * wid + 159) {
                f32x16 s0 = f32x16{}, s1 = f32x16{};
                { const LAS char* kb = shm + (64 * kap + r32) * BD_KP + hi * 16;
#pragma unroll
                  for (int ks = 0; ks < 4; ++ks) { const bf16x8 a0 = *(const LAS bf16x8*)(kb + ks * 32), a1 = *(const LAS bf16x8*)(kb + 32 * BD_KP + ks * 32);
                      s0 = MFMA32(a0, qf[ks], s0); s1 = MFMA32(a1, qf[ks], s1); } }
                { const int qrel = 32 * wid + r32; const int kb0 = 64 * kap - 128;
#pragma unroll
                  for (int r = 0; r < 16; ++r) { const int kr = kb0 + crow(r, hi); const int dist0 = qrel - kr, dist1 = dist0 - 32;
                      if (dist0 < 0 || dist0 > 128) s0[r] = -INFINITY; if (dist1 < 0 || dist1 > 128) s1[r] = -INFINITY; } }
                float mx = fmaxf(s0[0], s1[0]);
#pragma unroll
                for (int r = 1; r < 16; ++r) mx = fmaxf(mx, fmaxf(s0[r], s1[r]));
                mx = xmax32(mx);
                const float mnew = fmaxf(mrun, mx); const float alpha = __builtin_amdgcn_exp2f(mrun - mnew); mrun = mnew;
                float ps = 0.f;
#pragma unroll
                for (int r = 0; r < 16; ++r) { s0[r] = __builtin_amdgcn_exp2f(s0[r] - mnew); s1[r] = __builtin_amdgcn_exp2f(s1[r] - mnew); ps += s0[r] + s1[r]; }
                lrun = lrun * alpha + ps;
                o[0] *= alpha; o[1] *= alpha;
                u32x4 pw[4];
#pragma unroll
                for (int j = 0; j < 4; ++j) { pw[0][j] = cvtpk(s0[2 * j], s0[2 * j + 1]); pw[1][j] = cvtpk(s0[8 + 2 * j], s0[9 + 2 * j]); pw[2][j] = cvtpk(s1[2 * j], s1[2 * j + 1]); pw[3][j] = cvtpk(s1[8 + 2 * j], s1[9 + 2 * j]); }
                { const LAS char* vb = shm + BD_KBYTES + r32 * BD_VP + 128 * kap + hi * 8;
#pragma unroll
                  for (int dd = 0; dd < 2; ++dd)
#pragma unroll
                    for (int j = 0; j < 4; ++j) { const u32x2 lo = *(const LAS u32x2*)(vb + dd * 32 * BD_VP + j * 32), hh = *(const LAS u32x2*)(vb + dd * 32 * BD_VP + j * 32 + 16);
                        const u32x4 va = {lo.x, lo.y, hh.x, hh.y};
                        o[dd] = MFMA32(__builtin_bit_cast(bf16x8, va), __builtin_bit_cast(bf16x8, pw[j]), o[dd]); } }
            }
        }
        __syncthreads();
        lrun = xadd32(lrun);
        LAS char* ot = shm + wid * 9216;
        {
            float c3, c1 = 0.f, c2 = 0.f;
            if constexpr (!FINAL) { c3 = 1.f / lrun; if (hi == 0) LSE[(size_t)pidx * T_TOK * 8 + (unsigned)(row * 8 + head)] = mrun + __builtin_amdgcn_logf(lrun); }
            else {
                const float l1 = LSE[(unsigned)(row * 8 + head)], l2 = LSE[(size_t)T_TOK * 8 + (unsigned)(row * 8 + head)];
                const float M = fmaxf(mrun, fmaxf(l1, l2));
                const float w3 = __builtin_amdgcn_exp2f(mrun - M), w1 = __builtin_amdgcn_exp2f(l1 - M), w2 = __builtin_amdgcn_exp2f(l2 - M);
                const float inv = 1.f / (lrun * w3 + w1 + w2);
                c3 = w3 * inv; c1 = w1 * inv; c2 = w2 * inv;
            }
            if (hi == 0) *(LAS f32x4*)(ot + 8704 + r32 * 16) = (f32x4){c3, c1, c2, 0.f};
#pragma unroll
            for (int dd = 0; dd < 2; ++dd)
#pragma unroll
                for (int g = 0; g < 4; ++g) *(LAS f32x4*)(ot + r32 * 272 + (32 * dd + 8 * g + 4 * hi) * 4) = (f32x4){o[dd][4 * g], o[dd][4 * g + 1], o[dd][4 * g + 2], o[dd][4 * g + 3]};
        }
        asm volatile("s_waitcnt lgkmcnt(0)" ::: "memory");
        {
            const int rr = lane >> 4, ch = lane & 15;
            const unsigned rowq0 = rowbase + rho + d * (P0 + wid * 32);
#pragma unroll
            for (int i = 0; i < 8; ++i) {
                const int ri = 4 * i + rr; const unsigned rowg = rowq0 + d * ri;
                const f32x4 v = *(const LAS f32x4*)(ot + ri * 272 + ch * 16), cc = *(const LAS f32x4*)(ot + 8704 + ri * 16);
                if constexpr (!FINAL) {
                    st_bf16x4(OP + (size_t)pidx * T_TOK * 512 + (unsigned)(rowg * 512 + head * 64 + ch * 4), v * cc[0]);
                } else {
                    const u32x2 a = *(const u32x2*)(OP + (unsigned)(rowg * 512 + head * 64 + ch * 4)), bb = *(const u32x2*)(OP + (size_t)T_TOK * 512 + (unsigned)(rowg * 512 + head * 64 + ch * 4));
                    const f32x4 w = {v[0] * cc[0] + bf_lo(a.x) * cc[1] + bf_lo(bb.x) * cc[2], v[1] * cc[0] + bf_hi(a.x) * cc[1] + bf_hi(bb.x) * cc[2],
                                     v[2] * cc[0] + bf_lo(a.y) * cc[1] + bf_lo(bb.y) * cc[2], v[3] * cc[0] + bf_hi(a.y) * cc[1] + bf_hi(bb.y) * cc[2]};
                    st_bf16x4(AO + (unsigned)(rowg * 1024 + head * 64 + ch * 4), w);
                    float ss = (w[0] * w[0] + w[1] * w[1]) + (w[2] * w[2] + w[3] * w[3]);
                    ss += swz_xor<1>(ss); ss += swz_xor<2>(ss); ss += swz_xor<4>(ss); ss += swz_xor<8>(ss);
                    if (ch == 0) ssA[(unsigned)(rowg * 8 + head)] = ss;
                }
            }
        }
        __syncthreads();
        if (!has_next) break;
        u = un;
    }
#undef BD_ISSUE
#undef BD_WRITE
}

#define XB_TMO      128
#define XB_XCNT(j)  (256  + 64 * (j))
#define XB_XSUB(j)  (1280 + 64 * (j))
#define XB_XGEN(j)  (2304 + 64 * (j))
#define XB_TOP      3328
#define XB_TOPGEN   3392
#define XCD_BAR_WORDS 3456
#define XB_SPIN_CAP (1u << 18)
__device__ __forceinline__ unsigned xb_ld(unsigned* p)              { return __hip_atomic_load(p, __ATOMIC_RELAXED, __HIP_MEMORY_SCOPE_AGENT); }
__device__ __forceinline__ unsigned xb_add(unsigned* p, unsigned v) { return __hip_atomic_fetch_add(p, v, __ATOMIC_RELAXED, __HIP_MEMORY_SCOPE_AGENT); }
__device__ __forceinline__ unsigned xb_xcc_id() { return (unsigned)__builtin_amdgcn_s_getreg((3 << 11) | 20) & 0xFu; }
#define XB_SPIN(cond, bar) do { unsigned _sp = 0; while (cond) { __builtin_amdgcn_s_sleep(1); \
    if ((++_sp & 255u) == 0u) { if (xb_ld(&(bar)[XB_TMO])) break; if (_sp > XB_SPIN_CAP) { atomicAdd(&(bar)[XB_TMO], 1u); break; } } } } while (0)
struct XcdBarrier { unsigned* bar; unsigned x; volatile LAS unsigned* st; int wv; };
__device__ __forceinline__ XcdBarrier xcd_barrier_post(unsigned* bar, volatile LAS unsigned* st, int wv) {
    XcdBarrier b; b.bar = bar; b.x = xb_xcc_id(); b.st = st; b.wv = wv;
    if (wv == 0 && lane_id() == 0) (void)xb_add(&bar[XB_XCNT(b.x)], 1u);
    return b;
}
__device__ __forceinline__ void xcd_barrier_complete(unsigned* bar, unsigned x, unsigned& nloc, unsigned& nx) {
    const unsigned G = gridDim.x * gridDim.y * gridDim.z;
    unsigned sum, cnt, mine, sp = 0u;
    for (;;) {
        sum = 0u; cnt = 0u; mine = 0u;
#pragma unroll
        for (unsigned j = 0; j < 16; ++j) { const unsigned c = xb_ld(&bar[XB_XCNT(j)]); sum += c; cnt += (c > 0u) ? 1u : 0u; mine = (j == x) ? c : mine; }
        if (sum == G) break;
        __builtin_amdgcn_s_sleep(1);
        if ((++sp & 255u) == 0u) { if (xb_ld(&bar[XB_TMO])) break; if (sp > XB_SPIN_CAP) { atomicAdd(&bar[XB_TMO], 1u); break; } }
    }
    nloc = mine > 0u ? mine : 1u; nx = cnt > 0u ? cnt : 1u;
}
__device__ __forceinline__ void xcd_barrier(const XcdBarrier& b) {
    asm volatile("s_waitcnt vmcnt(0)" ::: "memory");
    __syncthreads();
    if (b.wv == 0 && lane_id() == 0) {
        unsigned* bar = b.bar;
        __builtin_amdgcn_s_waitcnt(0);
        unsigned nloc = b.st[0], nx = b.st[1];
        if (nloc == 0u) { xcd_barrier_complete(bar, b.x, nloc, nx); b.st[0] = nloc; b.st[1] = nx; }
        const unsigned old = xb_add(&bar[XB_XSUB(b.x)], 1u);
        const unsigned gen = old / nloc;
        if (old + 1u == (gen + 1u) * nloc) {
            __builtin_amdgcn_fence(__ATOMIC_RELEASE, "agent");
            asm volatile("s_waitcnt vmcnt(0)" ::: "memory");
            const unsigned og = xb_add(&bar[XB_TOP], 1u);
            const unsigned tg = og / nx;
            if (og + 1u == (tg + 1u) * nx) xb_add(&bar[XB_TOPGEN], 1u);
            else XB_SPIN(xb_ld(&bar[XB_TOPGEN]) == tg, bar);
            __builtin_amdgcn_fence(__ATOMIC_ACQUIRE, "agent");
            xb_add(&bar[XB_XGEN(b.x)], 1u);
            asm volatile("s_waitcnt vmcnt(0)" ::: "memory");
        } else {
            XB_SPIN(xb_ld(&bar[XB_XGEN(b.x)]) == gen, bar);
            __builtin_amdgcn_fence(__ATOMIC_ACQUIRE, "agent");
            asm volatile("s_waitcnt vmcnt(0)" ::: "memory");
        }
    }
    __syncthreads();
}

struct Args { const float* in[15]; float* out; unsigned char* ws; };
typedef const __attribute__((address_space(4))) unsigned char* kptr_t;
#define KA_PTR(idx) ({ kptr_t p_ = (kptr_t)__builtin_amdgcn_kernarg_segment_ptr(); asm volatile("" : "+s"(p_)); *(const __attribute__((address_space(4))) unsigned long long*)(p_ + 8 * (idx)); })
#define GASP __attribute__((address_space(1)))
#define K_IN(idx) ((const float*)(const GASP float*)KA_PTR(idx))
#define K_OUT() ((float*)(GASP float*)KA_PTR(15))
#define K_WS() ((unsigned char*)(GASP unsigned char*)KA_PTR(16))

#define CONV_LAYER(L) do { const int l_ = (L); unsigned char* ws_ = K_WS(); unsigned char* wl = ws_ + WS_W; \
        int tid_ = wv * 64 + lane_id(); asm volatile("" : "+v"(tid_)); const int lane_ = tid_ & 63, gw_ = bx * 8 + wv; \
        constexpr int I_IN = (IN_PAD / 64) * (DM / 64), I_UQ = (768 / 64) * (256 / 64), I_UKV = (1024 / 64) * (128 / 64), I_O = (DM / 64) * (DM / 64), I_1 = (DFF / 64) * (DM / 64), I_2 = (DM / 64) * (DFF / 64); \
        constexpr int I_LAYER = I_IN + I_UQ + I_UKV + I_O + I_1 + I_2; \
        _Pragma("unroll 1") for (int it = gw_; it < I_LAYER; it += NGW) { int r = it; \
            if (r < I_IN) { conv_item<1>(K_IN(1) + (size_t)l_ * DM * IN_COLS, DM, IN_COLS, (bf16_t*)(wl + WO_IN), nullptr, nullptr, 0, r / (DM / 64), r % (DM / 64), lane_); continue; } r -= I_IN; \
            if (r < I_UQ) { conv_item<2>(K_IN(4) + (size_t)l_ * 256 * 768, 256, 768, (bf16_t*)(wl + WO_UQ), K_IN(2) + l_ * 256, K_IN(2) + l_ * 256, 256, r / 4, r % 4, lane_); continue; } r -= I_UQ; \
            if (r < I_UKV) { conv_item<0>(K_IN(5) + (size_t)l_ * 128 * 1024, 128, 1024, (bf16_t*)(wl + WO_UKV), K_IN(3) + l_ * 128, K_IN(3) + l_ * 128, 128, r / 2, r % 2, lane_); continue; } r -= I_UKV; \
            if (r < I_O) { conv_item<0>(K_IN(8) + (size_t)l_ * DM * DM, DM, DM, (bf16_t*)(wl + WO_O), K_IN(6) + l_ * 512, K_IN(7) + l_ * 512, 512, r / (DM / 64), r % (DM / 64), lane_); continue; } r -= I_O; \
            if (r < I_1) { conv_item<0>(K_IN(11) + (size_t)l_ * DM * DFF, DM, DFF, (bf16_t*)(wl + WO_1), nullptr, nullptr, 0, r / (DM / 64), r % (DM / 64), lane_); continue; } r -= I_1; \
            conv_item<0>(K_IN(12) + (size_t)l_ * DFF * DM, DFF, DM, (bf16_t*)(wl + WO_2), nullptr, nullptr, 0, r / (DFF / 64), r % (DFF / 64), lane_); } } while (0)

__global__ void __launch_bounds__(512, 2) fwd_mega(Args args_unused) {
    extern __shared__ __attribute__((aligned(16))) unsigned char lds_raw[];
    LAS unsigned char* lds = (LAS unsigned char*)lds_raw;
    cg::grid_group grid = cg::this_grid();
    const int G = gridDim.x, bx = blockIdx.x;
    const int NGW = G * 8;
    const int wv = __builtin_amdgcn_readfirstlane(threadIdx.x >> 6);

    volatile LAS unsigned* bst = (volatile LAS unsigned*)(lds + 131072 + 512);
    if (wv == 0 && lane_id() < 2) bst[lane_id()] = 0u;
    __syncthreads();
    XcdBarrier xbar = xcd_barrier_post((unsigned*)K_WS(), bst, wv);
#if USE_XCD_BARRIER
#define GRID_SYNC() xcd_barrier(xbar)
#else
#define GRID_SYNC() grid.sync()
#endif

    if (PH_MASK & 1) {
        int tid = wv * 64 + lane_id(); asm volatile("" : "+v"(tid)); const int lane = tid & 63, wave = wv, gw = bx * 8 + wave;
        unsigned char* ws = K_WS();
        float* cs = (float*)(ws + WS_ROPE);
        for (int idx = bx * 512 + tid; idx < SEQ * 32; idx += G * 512) {
            const int pos = idx >> 5, i = idx & 31;
            double f = 1.0; for (int k = 0; k < i; ++k) f *= 0.74989420933245583;
            const double ang = (double)pos * f;
            const double kk = __builtin_rint(ang * 0.15915494309189535);
            const double r = ang - kk * 6.283185307179586477;
            const double r2 = r * r;
            double sn = 1.0, cn = 1.0;
#pragma unroll 1
            for (int n = 14; n >= 1; --n) { sn = 1.0 - sn * r2 / (double)((2 * n) * (2 * n + 1)); cn = 1.0 - cn * r2 / (double)((2 * n - 1) * (2 * n)); }
            cs[idx] = (float)cn; cs[SEQ * 32 + idx] = (float)(sn * r);
        }
        CONV_LAYER(0);
        const float* x_in = K_IN(0); bf16_t* XB = (bf16_t*)(ws + WS_XB);
        for (unsigned i = (unsigned)bx * 512 + tid; i < (unsigned)(T_TOK * DM / 8); i += (unsigned)G * 512) {
            const f32x4 a = ((const f32x4*)x_in)[2 * i], b = ((const f32x4*)x_in)[2 * i + 1];
            u32x4 w; w.x = cvtpk(a[0], a[1]); w.y = cvtpk(a[2], a[3]); w.z = cvtpk(b[0], b[1]); w.w = cvtpk(b[2], b[3]);
            ((u32x4*)XB)[i] = w;
        }
    }
    grid.sync();

#pragma unroll 1
    for (int l = 0; l < DEPTH; ++l) {
        if (l > 0) { CONV_LAYER(l); GRID_SYNC(); }
        for (int rep_ = 0; rep_ < ((DUP_MASK & 2) ? 2 : 1); ++rep_) if (PH_MASK & 2) {
            unsigned char* ws = K_WS(); unsigned char* wl = ws + WS_W;
            pg8::Gemm g{(const bf16_t*)(ws + WS_XB), (const bf16_t*)(wl + WO_IN), T_TOK, IN_PAD, DM}; pg8::StaticOrder S; S.init(T_TOK, IN_PAD, G, bx);
            EpiIn E{(bf16_t*)(ws + WS_QA), (bf16_t*)(ws + WS_KA), (bf16_t*)(ws + WS_VA), (bf16_t*)(ws + WS_CQ), (bf16_t*)(ws + WS_CKV), (bf16_t*)(ws + WS_KM),
                    (float*)(ws + WS_PCQ), (float*)(ws + WS_PCKV), (const float*)(ws + WS_ROPE)};
            pg8::gemm_phase<EpiIn, pg8::StaticOrder, true, true>(lds, g, S, E, wv);
        }
        GRID_SYNC();
        for (int rep_ = 0; rep_ < ((DUP_MASK & 4) ? 2 : 1); ++rep_) if (PH_MASK & 4) {
            unsigned char* ws = K_WS(); unsigned char* wl = ws + WS_W;
            float* rsq = (float*)(ws + WS_RSQ); const float* pcq = (const float*)(ws + WS_PCQ);
            pg8::Gemm g{(const bf16_t*)(ws + WS_CQ), (const bf16_t*)(wl + WO_UQ), T_TOK, 768, 256}; pg8::StaticOrder S; S.init(T_TOK, 768, G, bx);
            { int tid = wv * 64 + lane_id(); asm volatile("" : "+v"(tid)); Unit u; for (int i = 0; S.next(i, u); ++i) if (tid < 256) { const int row = u.pm * 256 + tid; const f32x4 pp = *(const f32x4*)(pcq + row * 4);
                  rsq[row] = QSCALE_M / sqrtf(((pp[0] + pp[1]) + (pp[2] + pp[3])) * (1.f / 256.f) + RMS_EPS); } }
            __syncthreads();
            EpiUpQ E{(bf16_t*)(ws + WS_QM), rsq, (const float*)(ws + WS_ROPE)};
            pg8::gemm_phase<EpiUpQ, pg8::StaticOrder, true, true>(lds, g, S, E, wv);
        }
        for (int rep_ = 0; rep_ < ((DUP_MASK & 8) ? 2 : 1); ++rep_) if (PH_MASK & 8) {
            unsigned char* ws = K_WS(); unsigned char* wl = ws + WS_W;
            float* rskv = (float*)(ws + WS_RSKV); const float* pckv = (const float*)(ws + WS_PCKV);
            pg8::Gemm g{(const bf16_t*)(ws + WS_CKV), (const bf16_t*)(wl + WO_UKV), T_TOK, 1024, 128}; pg8::StaticOrder S; S.init(T_TOK, 1024, G, bx);
            { int tid = wv * 64 + lane_id(); asm volatile("" : "+v"(tid)); Unit u; for (int i = 0; S.next(i, u); ++i) if (tid < 256) { const int row = u.pm * 256 + tid; const f32x4 pp = *(const f32x4*)(pckv + row * 4);
                  rskv[row] = 1.f / sqrtf(((pp[0] + pp[1]) + (pp[2] + pp[3])) * (1.f / 128.f) + RMS_EPS); } }
            __syncthreads();
            EpiUpKV E{(bf16_t*)(ws + WS_KM), (bf16_t*)(ws + WS_VM), rskv};
            pg8::gemm_phase<EpiUpKV, pg8::StaticOrder, true, true>(lds, g, S, E, wv);
        }
        for (int rep_ = 0; rep_ < ((DUP_MASK & 1024) ? 2 : 1); ++rep_) if (PH_MASK & 32) {
            unsigned char* ws = K_WS();
            band_phase<false>((LAS char*)lds, (const bf16_t*)(ws + WS_QA), (const bf16_t*)(ws + WS_KA), (const bf16_t*)(ws + WS_VA), (bf16_t*)(ws + WS_XB), (float*)(ws + WS_LSE),
                              nullptr, nullptr, bx, 2048, G, wv);
            __syncthreads();
        }
        GRID_SYNC();
#pragma unroll 1
        for (int step = 0; step < 2; ++step) {
            const bool do_mla = (step == 0) != (((bx >> 7) & 1) != 0);
            if (do_mla) {
                unsigned char* ws = K_WS();
                const int vb = (G % 8 == 0) ? (bx % 8) * (G / 8) + bx / 8 : bx;
                for (int p = vb; p < 256; p += G) {
                    const int bh = p >> 3, s = p & 7;
                    mla_unit((LAS char*)lds, (const bf16_t*)(ws + WS_QM), (const bf16_t*)(ws + WS_KM), (const bf16_t*)(ws + WS_VM), (bf16_t*)(ws + WS_AO), (float*)(ws + WS_SSB), bh >> 2, bh & 3, 15 - s, wv);
                    mla_unit((LAS char*)lds, (const bf16_t*)(ws + WS_QM), (const bf16_t*)(ws + WS_KM), (const bf16_t*)(ws + WS_VM), (bf16_t*)(ws + WS_AO), (float*)(ws + WS_SSB), bh >> 2, bh & 3, s, wv);
                }
            } else {
                unsigned char* ws = K_WS();
                band_phase<true>((LAS char*)lds, (const bf16_t*)(ws + WS_QA), (const bf16_t*)(ws + WS_KA), (const bf16_t*)(ws + WS_VA), (bf16_t*)(ws + WS_XB), (float*)(ws + WS_LSE),
                                 (bf16_t*)(ws + WS_AO), (float*)(ws + WS_SSA), bx, 1024, G, wv);
                __syncthreads();
            }
        }
        GRID_SYNC();
        if (PH_MASK & 64) {
            unsigned char* ws = K_WS(); unsigned char* wl = ws + WS_W;
            bf16_t* out = (bf16_t*)(ws + WS_ZB);
            ResLn R; R.ln = (l > 0); R.x32 = K_IN(0); R.zb = (const bf16_t*)out; R.mu = (const float*)(ws + WS_MU2); R.rs = (const float*)(ws + WS_RS2);
            { const float* gsrc = K_IN(13) + (l > 0 ? l - 1 : 0) * DM; const float* bsrc = K_IN(14) + (l > 0 ? l - 1 : 0) * DM; const int t_ = wv * 64 + lane_id();
              ((LAS float*)(lds + LDS_GB_OFF))[t_] = gsrc[t_]; ((LAS float*)(lds + LDS_GB_OFF))[t_ + 512] = gsrc[t_ + 512];
              ((LAS float*)(lds + LDS_GB_OFF + 4096))[t_] = bsrc[t_]; ((LAS float*)(lds + LDS_GB_OFF + 4096))[t_ + 512] = bsrc[t_ + 512]; }
            float* rsr = (float*)(ws + WS_RSR); float* rsbv = (float*)(ws + WS_RSB); const float* ssA = (const float*)(ws + WS_SSA); const float* ssB = (const float*)(ws + WS_SSB);
            pg8::Gemm g{(const bf16_t*)(ws + WS_AO), (const bf16_t*)(wl + WO_O), T_TOK, DM, DM}; pg8::StaticOrder S; S.init(T_TOK, DM, G, bx);
            { int tid = wv * 64 + lane_id(); asm volatile("" : "+v"(tid)); Unit u; for (int i = 0; S.next(i, u); ++i) if (tid < 256) { const int row = u.pm * 256 + tid;
                  const f32x4 a = *(const f32x4*)(ssA + row * 8), b = *(const f32x4*)(ssA + row * 8 + 4), c = *(const f32x4*)(ssB + row * 4);
                  const float ra = 1.f / sqrtf((((a[0] + a[1]) + (a[2] + a[3])) + ((b[0] + b[1]) + (b[2] + b[3]))) * (1.f / 512.f) + RMS_EPS);
                  const float rb = 1.f / sqrtf(((c[0] + c[1]) + (c[2] + c[3])) * (1.f / 512.f) + RMS_EPS);
                  rsr[row] = ra / rb; rsbv[row] = rb; } }
            __syncthreads();
            EpiOut E{R, out, rsr, rsbv, (LAS const unsigned char*)(lds + LDS_GB_OFF)};
            pg8::gemm_phase<EpiOut, pg8::StaticOrder, true, true>(lds, g, S, E, wv);
        }
        GRID_SYNC();
        if (PH_MASK & 128) { unsigned char* ws = K_WS(); ln_rows<true>((const bf16_t*)(ws + WS_ZB), nullptr, (bf16_t*)(ws + WS_XB), (float*)(ws + WS_MU1), (float*)(ws + WS_RS1), K_IN(9) + l * DM, K_IN(10) + l * DM, NGW, wv); }
        GRID_SYNC();
        for (int rep_ = 0; rep_ < ((DUP_MASK & 256) ? 2 : 1); ++rep_) if (PH_MASK & 256) {
            unsigned char* ws = K_WS(); unsigned char* wl = ws + WS_W;
            pg8::Gemm g{(const bf16_t*)(ws + WS_XB), (const bf16_t*)(wl + WO_1), T_TOK, DFF, DM}; pg8::StaticOrder S; S.init(T_TOK, DFF, G, bx);
            EpiFfn1 E{(bf16_t*)(ws + WS_HF)};
            pg8::gemm_phase<EpiFfn1, pg8::StaticOrder, true, true>(lds, g, S, E, wv);
        }
        GRID_SYNC();
        if (PH_MASK & 512) {
            unsigned char* ws = K_WS(); unsigned char* wl = ws + WS_W;
            pg8::Gemm g{(const bf16_t*)(ws + WS_HF), (const bf16_t*)(wl + WO_2), T_TOK, DM, DFF}; pg8::StaticOrder S; S.init(T_TOK, DM, G, bx);
            bf16_t* out = (bf16_t*)(ws + WS_ZB);
            ResLn R; R.ln = 1; R.x32 = nullptr; R.zb = (const bf16_t*)out; R.mu = (const float*)(ws + WS_MU1); R.rs = (const float*)(ws + WS_RS1);
            { const float* gsrc = K_IN(9) + l * DM; const float* bsrc = K_IN(10) + l * DM; const int t_ = wv * 64 + lane_id();
              ((LAS float*)(lds + LDS_GB_OFF))[t_] = gsrc[t_]; ((LAS float*)(lds + LDS_GB_OFF))[t_ + 512] = gsrc[t_ + 512];
              ((LAS float*)(lds + LDS_GB_OFF + 4096))[t_] = bsrc[t_]; ((LAS float*)(lds + LDS_GB_OFF + 4096))[t_ + 512] = bsrc[t_ + 512]; }
            __syncthreads();
            EpiFfn2 E{R, out, (LAS const unsigned char*)(lds + LDS_GB_OFF)};
            pg8::gemm_phase<EpiFfn2, pg8::StaticOrder, true, true>(lds, g, S, E, wv);
        }
        GRID_SYNC();
        if (PH_MASK & 128) { unsigned char* ws = K_WS();
            if (l + 1 < DEPTH) ln_rows<true>((const bf16_t*)(ws + WS_ZB), nullptr, (bf16_t*)(ws + WS_XB), (float*)(ws + WS_MU2), (float*)(ws + WS_RS2), K_IN(13) + l * DM, K_IN(14) + l * DM, NGW, wv);
            else ln_rows<false>((const bf16_t*)(ws + WS_ZB), K_OUT(), nullptr, nullptr, nullptr, K_IN(13) + l * DM, K_IN(14) + l * DM, NGW, wv); }
        GRID_SYNC();
    }
}

extern "C" void kernel_launch(void* const* d_in, const int* in_sizes, int n_in, void* d_out, int out_size, void* d_ws, size_t ws_size, hipStream_t stream) {
    static int grid = 0;
    if (grid == 0) {
        if (n_in != 15 || out_size != T_TOK * DM || ws_size < WS_END) { fprintf(stderr, "kernel_launch: unexpected shapes (n_in %d out %d ws %zu)\n", n_in, out_size, ws_size); grid = -1; return; }
        int dev = 0, cus = 0, per_cu = 0;
        hipGetDevice(&dev);
        hipDeviceGetAttribute(&cus, hipDeviceAttributeMultiprocessorCount, dev);
        if (hipFuncSetAttribute((const void*)fwd_mega, hipFuncAttributeMaxDynamicSharedMemorySize, LDS_BYTES) != hipSuccess) { fprintf(stderr, "kernel_launch: hipFuncSetAttribute failed\n"); grid = -1; return; }
        if (hipOccupancyMaxActiveBlocksPerMultiprocessor(&per_cu, (const void*)fwd_mega, 512, LDS_BYTES) != hipSuccess || per_cu < 1) { fprintf(stderr, "kernel_launch: occupancy query gave %d\n", per_cu); per_cu = 1; }
        (void)hipGetLastError();
        grid = cus * per_cu;
        fprintf(stderr, "kernel_launch: grid %d (cus %d x %d)\n", grid, cus, per_cu);
    }
    if (grid < 0) return;
    if (hipMemsetAsync((char*)d_ws + WS_CTL, 0, CTL_ZERO_BYTES, stream) != hipSuccess) { fprintf(stderr, "kernel_launch: memset failed\n"); return; }
    Args a{};
    for (int i = 0; i < 15; ++i) a.in[i] = (const float*)d_in[i];
    a.out = (float*)d_out; a.ws = (unsigned char*)d_ws;
    void* kargs[] = {&a};
    hipError_t e = hipLaunchCooperativeKernel((const void*)fwd_mega, dim3(grid), dim3(512), kargs, LDS_BYTES, stream);
    if (e != hipSuccess) fprintf(stderr, "kernel_launch: cooperative launch failed: %s (grid %d)\n", hipGetErrorString(e), grid);
}
```

```cpp
#include <hip/hip_runtime.h>
#include <hip/hip_cooperative_groups.h>
#include <cstdio>
#include <cstdint>
namespace cg = cooperative_groups;

#ifndef DUP_MASK
#define DUP_MASK 0
#endif
#ifndef PH_MASK
#define PH_MASK 1023
#endif
#ifndef USE_XCD_BARRIER
#define USE_XCD_BARRIER 1
#endif

__device__ __forceinline__ int lane_id_v() { int l; asm volatile("v_mbcnt_lo_u32_b32 %0, -1, 0\n\tv_mbcnt_hi_u32_b32 %0, -1, %0" : "=v"(l)); return l; }
namespace pg8 {
#define PG8_LAS __attribute__((address_space(3)))
typedef unsigned short bf16_t;
typedef short bf16x8 __attribute__((ext_vector_type(8)));
typedef float f32x4 __attribute__((ext_vector_type(4)));
typedef unsigned u32x4 __attribute__((ext_vector_type(4)));
typedef unsigned u32x2 __attribute__((ext_vector_type(2)));
constexpr int BM = 256, BK = 64, HALF = 128, HTB = HALF * BK * 2, STAGE_BYTES = 8 * HTB, NXCD = 8, WGM = 8;

__host__ __device__ __forceinline__ int lds_byte(int r, int c) { const int st = (r >> 4) * 2 + (c >> 5), rr = r & 15, cc = c & 31, ob = rr * 64 + cc * 2; return st * 1024 + (ob ^ (((ob >> 9) & 1) << 5)); }
__host__ __device__ __forceinline__ void stage_rc(int b, int& R, int& C) { const int st = b / 1024, sb = b % 1024, swz = sb ^ (((sb >> 9) & 1) << 5); R = (st >> 1) * 16 + swz / 64; C = (st & 1) * 32 + (swz % 64) / 2; }
__host__ __device__ __forceinline__ int perm32(int rho) { const int n = rho >> 4, i = rho & 15; return 8 * (i >> 2) + 4 * n + (i & 3); }

struct Unit { int pm, pn; };
struct Gemm { const bf16_t* A; const bf16_t* Bt; int M, N, K; };

struct StaticOrder {
    int nM, nN, nwg, G, c;
    __host__ __device__ void init(int M, int N, int G_, int c_) { nM = M / BM; nN = N / BM; nwg = nM * nN; G = G_; c = c_; }
    __host__ __device__ bool next(int i, Unit& u) const {
        const long L = (long)i * G + c; if (L >= nwg) return false;
        int wgid = (int)L; { const int q = nwg / NXCD, r = nwg % NXCD, xcd = wgid % NXCD, off = wgid / NXCD; wgid = (xcd < r ? xcd * (q + 1) : r * (q + 1) + (xcd - r) * q) + off; }
        const int nig = WGM * nN, gid = wgid / nig, fm = gid * WGM, gsz = (nM - fm) < WGM ? (nM - fm) : WGM;
        u.pm = fm + ((wgid % nig) % gsz); u.pn = (wgid % nig) / gsz; return true;
    }
};

__device__ __forceinline__ unsigned cvt_pk_bf16(float lo, float hi) { unsigned r; asm volatile("v_cvt_pk_bf16_f32 %0, %1, %2" : "=v"(r) : "v"(lo), "v"(hi)); return r; }

template <class Epi, class Sched, bool ALIGN_EPI = false, bool SP2 = false>
__device__ __forceinline__ void gemm_phase(PG8_LAS unsigned char* lds, const Gemm g, const Sched& S, const Epi& E, int wv) {
    int tid_o = wv * 64 + lane_id_v(); asm volatile("" : "+v"(tid_o));
    const int tid = tid_o, wid = __builtin_amdgcn_readfirstlane(tid >> 6), lane = tid & 63, wr = wid >> 2, wc = wid & 3, fr = lane & 15, fq = lane >> 4;
    const int K = g.K, nt = K / BK;
    unsigned voffA[2], voffB[2];
#pragma unroll
    for (int i = 0; i < 2; ++i) { int R, C; stage_rc(tid * 16 + i * 8192, R, C); const int Rb = Epi::PERM ? ((R & ~31) + perm32(R & 31)) : R;
        voffA[i] = (unsigned)(R * K + C) * 2u; voffB[i] = (unsigned)(Rb * K + C) * 2u; }
    const size_t kstep = (size_t)(BK * 2);
    const size_t hstep = (size_t)HALF * K * 2;
    const size_t tstep = 2 * hstep;
    const unsigned ldsw = (unsigned)wid * 1024u;
    const int aoff = lds_byte(wr * 64 + fr, fq * 8), boff = lds_byte(wc * 32 + fr, fq * 8);
#define PG8_SA(b, h) (((b) * 2 + (h)) * HTB)
#define PG8_SB(b, h) ((4 + (b) * 2 + (h)) * HTB)
#define PG8_STAGE(bufoff, gbase, voff) do { _Pragma("unroll") for (int _i = 0; _i < 2; ++_i) \
        __builtin_amdgcn_global_load_lds((const unsigned*)((const char*)(gbase) + (voff)[_i]), (PG8_LAS unsigned*)(lds + (bufoff) + ldsw + _i * 8192), 16, 0, 0); } while (0)
#define PG8_LDA(dst, b, h) do { _Pragma("unroll") for (int m = 0; m < 4; ++m) _Pragma("unroll") for (int k = 0; k < 2; ++k) dst[m][k] = *(const PG8_LAS bf16x8*)(lds + PG8_SA(b, h) + aoff + m * 2048 + k * 1024); } while (0)
#define PG8_LDB(dst, b, h) do { _Pragma("unroll") for (int n = 0; n < 2; ++n) _Pragma("unroll") for (int k = 0; k < 2; ++k) dst[n][k] = *(const PG8_LAS bf16x8*)(lds + PG8_SB(b, h) + boff + n * 2048 + k * 1024); } while (0)
#define PG8_MMA(ai, bj, At, Bt) do { __builtin_amdgcn_s_setprio(1); _Pragma("unroll") for (int m = 0; m < 4; ++m) _Pragma("unroll") for (int n = 0; n < 2; ++n) _Pragma("unroll") for (int k = 0; k < 2; ++k) \
        acc[ai][bj][m][n] = __builtin_amdgcn_mfma_f32_16x16x32_bf16(Bt[n][k], At[m][k], acc[ai][bj][m][n], 0, 0, 0); __builtin_amdgcn_s_setprio(0); } while (0)
#define PG8_WAIT_V(n) asm volatile("s_waitcnt vmcnt(" #n ")" ::: "memory")
#define PG8_WAIT_L(n) asm volatile("s_waitcnt lgkmcnt(" #n ")" ::: "memory")
#define PG8_BAR __builtin_amdgcn_s_barrier()
#define PG8_SCHED __builtin_amdgcn_sched_barrier(0)
    Unit cur, nxt; int ui = 0;
    if (!S.next(0, cur)) return;
    f32x4 acc[2][2][4][2];
#pragma unroll
    for (int a = 0; a < 2; ++a)
#pragma unroll
        for (int b = 0; b < 2; ++b)
#pragma unroll
            for (int m = 0; m < 4; ++m)
#pragma unroll
                for (int n = 0; n < 2; ++n) acc[a][b][m][n] = (f32x4){0.f, 0.f, 0.f, 0.f};
    bf16x8 At[4][2], B0[2][2], B1[2][2];
    const char* cA = (const char*)g.A + (size_t)cur.pm * tstep; const char* cB = (const char*)g.Bt + (size_t)cur.pn * tstep;
    if constexpr (SP2) {
        PG8_STAGE(PG8_SB(0, 0), cB, voffB); PG8_STAGE(PG8_SB(0, 1), cB + hstep, voffB); PG8_STAGE(PG8_SA(0, 0), cA, voffA); PG8_STAGE(PG8_SA(0, 1), cA + hstep, voffA);
        if (wr == 1) PG8_BAR;
        PG8_WAIT_V(2); PG8_BAR;
        PG8_STAGE(PG8_SB(1, 0), cB + kstep, voffB); PG8_STAGE(PG8_SA(1, 0), cA + kstep, voffA); PG8_STAGE(PG8_SB(1, 1), cB + hstep + kstep, voffB);
        PG8_WAIT_V(6); PG8_BAR;
    } else {
        PG8_STAGE(PG8_SB(0, 0), cB, voffB); PG8_STAGE(PG8_SA(0, 0), cA, voffA); PG8_STAGE(PG8_SB(0, 1), cB + hstep, voffB); PG8_STAGE(PG8_SA(0, 1), cA + hstep, voffA);
        if (wr == 1) PG8_BAR;
        PG8_WAIT_V(4); PG8_BAR;
        PG8_STAGE(PG8_SB(1, 0), cB + kstep, voffB); PG8_STAGE(PG8_SA(1, 0), cA + kstep, voffA); PG8_STAGE(PG8_SB(1, 1), cB + hstep + kstep, voffB);
        PG8_WAIT_V(6); PG8_BAR;
    }
    for (;;) {
        const bool has_next = S.next(ui + 1, nxt);
        const char* nA = has_next ? (const char*)g.A + (size_t)nxt.pm * tstep : cA; const char* nB = has_next ? (const char*)g.Bt + (size_t)nxt.pn * tstep : cB;
        for (int t = 0; t < nt; t += 2) {
            const bool last = (t == nt - 2);
            if constexpr (Epi::MID) { if (t == (nt >> 1)) { int t2 = lane_id_v(); asm volatile("" : "+v"(t2)); E.mid(acc, cur, wr, wc, t2 & 15, (t2 >> 4) & 3); } }
            const char* a1 = cA + (size_t)(t + 1) * kstep;
            const char* a2 = last ? nA : cA + (size_t)(t + 2) * kstep; const char* b2 = last ? nB : cB + (size_t)(t + 2) * kstep;
            const char* a3 = a2 + kstep; const char* b3 = b2 + kstep;
            if constexpr (SP2) {
            PG8_LDB(B0, 0, 0); PG8_LDB(B1, 0, 1); PG8_SCHED; PG8_LDA(At, 0, 0); PG8_STAGE(PG8_SA(1, 1), a1 + hstep, voffA);
            PG8_WAIT_V(8); PG8_WAIT_L(0); PG8_BAR; PG8_MMA(0, 0, At, B0); PG8_MMA(0, 1, At, B1); PG8_BAR; PG8_SCHED;
            PG8_LDA(At, 0, 1); PG8_STAGE(PG8_SB(0, 0), b2, voffB); PG8_STAGE(PG8_SB(0, 1), b2 + hstep, voffB); PG8_STAGE(PG8_SA(0, 0), a2, voffA);
            PG8_WAIT_V(8); PG8_WAIT_L(0); PG8_BAR; PG8_MMA(1, 0, At, B0); PG8_MMA(1, 1, At, B1); PG8_BAR; PG8_SCHED;
            PG8_LDB(B0, 1, 0); PG8_LDB(B1, 1, 1); PG8_SCHED; PG8_LDA(At, 1, 0); PG8_STAGE(PG8_SA(0, 1), a2 + hstep, voffA);
            PG8_WAIT_V(8); PG8_WAIT_L(0); PG8_BAR; PG8_MMA(0, 0, At, B0); PG8_MMA(0, 1, At, B1); PG8_BAR; PG8_SCHED;
            PG8_LDA(At, 1, 1); PG8_STAGE(PG8_SB(1, 0), b3, voffB); PG8_STAGE(PG8_SB(1, 1), b3 + hstep, voffB); PG8_STAGE(PG8_SA(1, 0), a3, voffA);
            PG8_WAIT_V(8); PG8_WAIT_L(0); PG8_BAR; PG8_MMA(1, 0, At, B0); PG8_MMA(1, 1, At, B1); PG8_BAR; PG8_SCHED;
            } else {
            PG8_LDB(B0, 0, 0); PG8_SCHED; PG8_LDA(At, 0, 0); PG8_STAGE(PG8_SA(1, 1), a1 + hstep, voffA);
            PG8_WAIT_L(8); PG8_BAR; PG8_WAIT_L(0); PG8_MMA(0, 0, At, B0); PG8_BAR; PG8_SCHED;
            PG8_LDB(B1, 0, 1); PG8_STAGE(PG8_SB(0, 0), b2, voffB);
            PG8_BAR; PG8_WAIT_L(0); PG8_MMA(0, 1, At, B1); PG8_BAR;
            PG8_LDA(At, 0, 1); PG8_STAGE(PG8_SA(0, 0), a2, voffA);
            PG8_BAR; PG8_WAIT_L(0); PG8_MMA(1, 0, At, B0); PG8_BAR; PG8_SCHED;
            PG8_STAGE(PG8_SB(0, 1), b2 + hstep, voffB);
            PG8_WAIT_V(6); PG8_BAR; PG8_MMA(1, 1, At, B1); PG8_BAR;
            PG8_LDB(B0, 1, 0); PG8_SCHED; PG8_LDA(At, 1, 0); PG8_STAGE(PG8_SA(0, 1), a2 + hstep, voffA);
            PG8_WAIT_L(8); PG8_BAR; PG8_WAIT_L(0); PG8_MMA(0, 0, At, B0); PG8_BAR; PG8_SCHED;
            PG8_LDB(B1, 1, 1); PG8_STAGE(PG8_SB(1, 0), b3, voffB);
            PG8_BAR; PG8_WAIT_L(0); PG8_MMA(0, 1, At, B1); PG8_BAR;
            PG8_LDA(At, 1, 1); PG8_STAGE(PG8_SA(1, 0), a3, voffA);
            PG8_BAR; PG8_WAIT_L(0); PG8_MMA(1, 0, At, B0); PG8_BAR; PG8_SCHED;
            PG8_STAGE(PG8_SB(1, 1), b3 + hstep, voffB);
            PG8_WAIT_V(6); PG8_BAR; PG8_MMA(1, 1, At, B1); PG8_BAR;
            }
        }
        if constexpr (ALIGN_EPI) { if (wr == 0) PG8_BAR; }
        { int t2 = lane_id_v(); asm volatile("" : "+v"(t2)); E(acc, cur, wr, wc, t2 & 15, (t2 >> 4) & 3); }
        if (!has_next) break;
#pragma unroll
        for (int a = 0; a < 2; ++a)
#pragma unroll
            for (int b = 0; b < 2; ++b)
#pragma unroll
                for (int m = 0; m < 4; ++m)
#pragma unroll
                    for (int n = 0; n < 2; ++n) acc[a][b][m][n] = (f32x4){0.f, 0.f, 0.f, 0.f};
        cur = nxt; cA = nA; cB = nB; ++ui;
        if constexpr (ALIGN_EPI) { if (wr == 1) PG8_BAR; }
    }
    PG8_WAIT_V(0);
    if constexpr (!ALIGN_EPI) { if (wr == 0) PG8_BAR; }
    PG8_BAR;
#undef PG8_SA
#undef PG8_SB
#undef PG8_STAGE
#undef PG8_LDA
#undef PG8_LDB
#undef PG8_MMA
#undef PG8_WAIT_V
#undef PG8_WAIT_L
#undef PG8_BAR
#undef PG8_SCHED
}
}

using pg8::bf16_t; using pg8::bf16x8; using pg8::f32x4; using pg8::u32x4; using pg8::u32x2; using pg8::Unit; using pg8::cvt_pk_bf16;
typedef float f32x16 __attribute__((ext_vector_type(16)));
#define LAS __attribute__((address_space(3)))

constexpr int T_TOK = 32768, SEQ = 4096, DM = 1024, NBATCH = 8, DEPTH = 4, DFF = 4096;
constexpr int IN_COLS = 1984, IN_PAD = 2048;
constexpr float ALPHA = 1.6817928305074290f;
constexpr float LN_EPS = 1e-5f, RMS_EPS = 1e-6f;
constexpr float LOG2E = 1.4426950408889634f;
constexpr float QSCALE_A = 0.125f * LOG2E;
constexpr float QSCALE_M = 0.07216878364870322f * LOG2E;

constexpr size_t MiB = 1u << 20;
constexpr size_t WS_CTL = 0, CTL_ZERO_BYTES = 64 * 1024;
constexpr size_t WS_ROPE = 1 * MiB;
constexpr size_t WS_PCQ = 2 * MiB;
constexpr size_t WS_PCKV = 2 * MiB + 512 * 1024;
constexpr size_t WS_SSA = 3 * MiB;
constexpr size_t WS_SSB = 4 * MiB;
constexpr size_t WS_LSE = 5 * MiB;
constexpr size_t WS_RSQ = 7 * MiB, WS_RSKV = 7 * MiB + 128 * 1024, WS_RSR = 7 * MiB + 256 * 1024, WS_RSB = 7 * MiB + 384 * 1024;
constexpr size_t WS_MU1 = 7 * MiB + 512 * 1024, WS_RS1 = 7 * MiB + 640 * 1024, WS_MU2 = 7 * MiB + 768 * 1024, WS_RS2 = 7 * MiB + 896 * 1024;
constexpr size_t WS_W = 8 * MiB;
constexpr size_t W_LAYER_BYTES = 23 * MiB;
constexpr size_t WS_ZB = 32 * MiB;
constexpr size_t WO_IN = 0, WO_UQ = 4 * MiB, WO_UKV = 4 * MiB + 512 * 1024, WO_O = 5 * MiB, WO_1 = 7 * MiB, WO_2 = 15 * MiB;
constexpr size_t WS_XB = 100 * MiB;
constexpr size_t WS_QA = 164 * MiB, WS_KA = 196 * MiB, WS_VA = 228 * MiB, WS_CQ = 260 * MiB, WS_CKV = 276 * MiB;
constexpr size_t WS_QM = 284 * MiB, WS_KM = 332 * MiB, WS_VM = 380 * MiB, WS_AO = 412 * MiB, WS_END = 476 * MiB;
constexpr size_t WS_HF = 164 * MiB;

constexpr int LDS_BYTES = 147456;

typedef float f32x2_t __attribute__((ext_vector_type(2))); typedef __bf16 bf16x2_t __attribute__((ext_vector_type(2)));
__device__ __forceinline__ unsigned cvtpk(float lo, float hi) { f32x2_t v = {lo, hi}; bf16x2_t b = __builtin_convertvector(v, bf16x2_t); return __builtin_bit_cast(unsigned, b); }
__device__ __forceinline__ float bf_lo(unsigned u) { return __uint_as_float(u << 16); }
__device__ __forceinline__ float bf_hi(unsigned u) { return __uint_as_float(u & 0xffff0000u); }
__device__ __forceinline__ void st_bf16x4(bf16_t* p, f32x4 v) { u32x2 w; w.x = cvtpk(v[0], v[1]); w.y = cvtpk(v[2], v[3]); *(u32x2*)p = w; }
template <int XM> __device__ __forceinline__ float swz_xor(float v) { return __int_as_float(__builtin_amdgcn_ds_swizzle(__float_as_int(v), (XM << 10) | 0x1f)); }
__device__ __forceinline__ float xadd32(float v) { auto rr = __builtin_amdgcn_permlane32_swap(__float_as_uint(v), __float_as_uint(v), false, false); return __uint_as_float(rr[0]) + __uint_as_float(rr[1]); }
__device__ __forceinline__ float xmax32(float v) { auto rr = __builtin_amdgcn_permlane32_swap(__float_as_uint(v), __float_as_uint(v), false, false); return fmaxf(__uint_as_float(rr[0]), __uint_as_float(rr[1])); }
__device__ __forceinline__ float wave_sum(float v) {
    v += swz_xor<1>(v); v += swz_xor<2>(v); v += swz_xor<4>(v); v += swz_xor<8>(v); v += swz_xor<16>(v);
    return xadd32(v);
}
__device__ __forceinline__ int lane_id() { return lane_id_v(); }
__device__ __forceinline__ int crow(int r, int hi) { return (r & 3) + 8 * (r >> 2) + 4 * hi; }

__device__ __forceinline__ void st_bf16x8(bf16_t* p, f32x4 a, f32x4 b) { u32x4 w; w.x = cvtpk(a[0], a[1]); w.y = cvtpk(a[2], a[3]); w.z = cvtpk(b[0], b[1]); w.w = cvtpk(b[2], b[3]); *(u32x4*)p = w; }
__device__ __forceinline__ float sumsq8(f32x4 a, f32x4 b) { return ((a[0] * a[0] + a[1] * a[1]) + (a[2] * a[2] + a[3] * a[3])) + ((b[0] * b[0] + b[1] * b[1]) + (b[2] * b[2] + b[3] * b[3])); }
struct EpiIn {
    static constexpr bool PERM = true, MID = false;
    bf16_t *QA, *KA, *VA, *CQ, *CKV, *KM; float *pcq, *pckv; const float* cs;
    __device__ __forceinline__ void operator()(const f32x4 (&acc)[2][2][4][2], const Unit& u, int wr, int wc, int fr, int fq) const {
        const int pn = u.pn; const int row0 = u.pm * 256 + wr * 64 + fr;
        if (pn < 4) {
            bf16_t* base = (pn < 2) ? QA : KA; const float sc = (pn < 2) ? QSCALE_A : 1.f;
#pragma unroll
            for (int ai = 0; ai < 2; ++ai) {
                f32x4 cv[4][4];
#pragma unroll
                for (int m = 0; m < 4; ++m) { const int pos = (row0 + ai * 128 + m * 16) & (SEQ - 1); const float* cp = cs + pos * 32 + 8 * fq;
                    cv[m][0] = *(const f32x4*)cp; cv[m][1] = *(const f32x4*)(cp + 4); cv[m][2] = *(const f32x4*)(cp + SEQ * 32); cv[m][3] = *(const f32x4*)(cp + SEQ * 32 + 4); }
#pragma unroll
                for (int m = 0; m < 4; ++m) {
                    const int row = row0 + ai * 128 + m * 16;
                    const f32x4 c0 = cv[m][0] * sc, c1 = cv[m][1] * sc, s0 = cv[m][2] * sc, s1 = cv[m][3] * sc;
                    const f32x4 xa0 = acc[ai][0][m][0], xa1 = acc[ai][0][m][1], xb0 = acc[ai][1][m][0], xb1 = acc[ai][1][m][1];
                    bf16_t* p = base + (unsigned)(row * 512 + 256 * (pn & 1) + 64 * wc + 8 * fq);
                    st_bf16x8(p, xa0 * c0 - xb0 * s0, xa1 * c1 - xb1 * s1); st_bf16x8(p + 32, xb0 * c0 + xa0 * s0, xb1 * c1 + xa1 * s1);
                }
                asm volatile("" ::: "memory");
            }
        } else if (pn < 7) {
            bf16_t* dst = (pn < 6) ? VA : CQ; const int ld = (pn < 6) ? 512 : 256; const int cb = (pn == 5) ? 256 : 0;
#pragma unroll
            for (int ai = 0; ai < 2; ++ai)
#pragma unroll
                for (int m = 0; m < 4; ++m) {
                    const int row = row0 + ai * 128 + m * 16; float ss = 0.f;
#pragma unroll
                    for (int bj = 0; bj < 2; ++bj) { ss += sumsq8(acc[ai][bj][m][0], acc[ai][bj][m][1]);
                        st_bf16x8(dst + (unsigned)(row * ld + cb + 128 * bj + 32 * wc + 8 * fq), acc[ai][bj][m][0], acc[ai][bj][m][1]); }
                    if (pn == 6) { ss += swz_xor<16>(ss); ss = xadd32(ss); if (fq == 0) pcq[row * 4 + wc] = ss; }
                }
        } else {
#pragma unroll
            for (int ai = 0; ai < 2; ++ai)
#pragma unroll
                for (int m = 0; m < 4; ++m) {
                    const int row = row0 + ai * 128 + m * 16; float ss = 0.f;
                    if (wc < 3) { ss += sumsq8(acc[ai][0][m][0], acc[ai][0][m][1]); st_bf16x8(CKV + (unsigned)(row * 128 + 32 * wc + 8 * fq), acc[ai][0][m][0], acc[ai][0][m][1]); }
                    if (wc == 0) { ss += sumsq8(acc[ai][1][m][0], acc[ai][1][m][1]); st_bf16x8(CKV + (unsigned)(row * 128 + 96 + 8 * fq), acc[ai][1][m][0], acc[ai][1][m][1]); }
                    ss += swz_xor<16>(ss); ss = xadd32(ss); if (fq == 0) pckv[row * 4 + wc] = ss;
                    if (wc == 3) {
                        const int pos = row & (SEQ - 1); const float* cp = cs + pos * 32 + 8 * fq;
                        const f32x4 c0 = *(const f32x4*)cp, c1 = *(const f32x4*)(cp + 4), s0 = *(const f32x4*)(cp + SEQ * 32), s1 = *(const f32x4*)(cp + SEQ * 32 + 4);
                        const f32x4 xa0 = acc[ai][0][m][0], xa1 = acc[ai][0][m][1], xb0 = acc[ai][1][m][0], xb1 = acc[ai][1][m][1];
                        const f32x4 o10 = xa0 * c0 - xb0 * s0, o11 = xa1 * c1 - xb1 * s1, o20 = xb0 * c0 + xa0 * s0, o21 = xb1 * c1 + xa1 * s1;
#pragma unroll
                        for (int h = 0; h < 4; ++h) { bf16_t* p = KM + (unsigned)(row * 768 + h * 192 + 128 + 8 * fq); st_bf16x8(p, o10, o11); st_bf16x8(p + 32, o20, o21); }
                    }
                }
        }
    }
};

struct EpiUpQ {
    static constexpr bool PERM = true, MID = false;
    bf16_t* QM; const float* rsq; const float* cs;
    __device__ __forceinline__ void operator()(const f32x4 (&acc)[2][2][4][2], const Unit& u, int wr, int wc, int fr, int fq) const {
        const int pn = u.pn; const int row0 = u.pm * 256 + wr * 64 + fr;
#pragma unroll
        for (int ai = 0; ai < 2; ++ai)
#pragma unroll
            for (int m = 0; m < 4; ++m) {
                const int row = row0 + ai * 128 + m * 16;
                const float rs = rsq[row];
                if (pn < 2) {
#pragma unroll
                    for (int bj = 0; bj < 2; ++bj)
                        st_bf16x8(QM + (unsigned)(row * 768 + (2 * pn + bj) * 192 + 32 * wc + 8 * fq), acc[ai][bj][m][0] * rs, acc[ai][bj][m][1] * rs);
                } else {
                    const int pos = row & (SEQ - 1); const float* cp = cs + pos * 32 + 8 * fq;
                    const f32x4 c0 = *(const f32x4*)cp * rs, c1 = *(const f32x4*)(cp + 4) * rs, s0 = *(const f32x4*)(cp + SEQ * 32) * rs, s1 = *(const f32x4*)(cp + SEQ * 32 + 4) * rs;
                    const f32x4 xa0 = acc[ai][0][m][0], xa1 = acc[ai][0][m][1], xb0 = acc[ai][1][m][0], xb1 = acc[ai][1][m][1];
                    bf16_t* p = QM + (unsigned)(row * 768 + wc * 192 + 128 + 8 * fq);
                    st_bf16x8(p, xa0 * c0 - xb0 * s0, xa1 * c1 - xb1 * s1); st_bf16x8(p + 32, xb0 * c0 + xa0 * s0, xb1 * c1 + xa1 * s1);
                }
                if (m & 1) asm volatile("" ::: "memory");
            }
    }
};

struct EpiUpKV {
    static constexpr bool PERM = true, MID = false;
    bf16_t *KM, *VM; const float* rskv;
    __device__ __forceinline__ void operator()(const f32x4 (&acc)[2][2][4][2], const Unit& u, int wr, int wc, int fr, int fq) const {
        const int pn = u.pn; const int row0 = u.pm * 256 + wr * 64 + fr;
#pragma unroll
        for (int ai = 0; ai < 2; ++ai)
#pragma unroll
            for (int m = 0; m < 4; ++m) {
                const int row = row0 + ai * 128 + m * 16;
                const float rs = rskv[row];
                st_bf16x8(KM + (unsigned)(row * 768 + pn * 192 + 32 * wc + 8 * fq), acc[ai][0][m][0] * rs, acc[ai][0][m][1] * rs);
                st_bf16x8(VM + (unsigned)(row * 512 + pn * 128 + 32 * wc + 8 * fq), acc[ai][1][m][0] * rs, acc[ai][1][m][1] * rs);
                if (m & 1) asm volatile("" ::: "memory");
            }
    }
};

constexpr int LDS_GB_OFF = 131072 + 1024;
struct ResLn { const float* x32; const bf16_t* zb; const float* mu; const float* rs; int ln; };
__device__ __forceinline__ void ld8_bf16(const bf16_t* p, f32x4& a, f32x4& b) { const u32x4 w = *(const u32x4*)p; a = (f32x4){bf_lo(w.x), bf_hi(w.x), bf_lo(w.y), bf_hi(w.y)}; b = (f32x4){bf_lo(w.z), bf_hi(w.z), bf_lo(w.w), bf_hi(w.w)}; }
__device__ __forceinline__ void resid_epilogue(const f32x4 (&acc)[2][2][4][2], const ResLn& R, bf16_t* zout, const float* rsb, LAS const unsigned char* lds_gb, const Unit& u, int wr, int wc, int fr, int fq) {
    const int row0 = u.pm * 256 + wr * 64 + fr; const int col0 = u.pn * 256 + 32 * wc + 8 * fq;
    if (R.ln) {
#pragma unroll
        for (int ai = 0; ai < 2; ++ai) {
            u32x4 zr[4][2]; float mu[4], rs[4], rb[4];
#pragma unroll
            for (int m = 0; m < 4; ++m) { const int row = row0 + ai * 128 + m * 16; rb[m] = rsb ? rsb[row] : 1.f; mu[m] = R.mu[row]; rs[m] = R.rs[row];
                zr[m][0] = *(const u32x4*)(R.zb + (unsigned)(row * DM + col0)); zr[m][1] = *(const u32x4*)(R.zb + (unsigned)(row * DM + col0 + 128)); }
#pragma unroll
            for (int bj = 0; bj < 2; ++bj) {
                const int col = col0 + 128 * bj;
                const f32x4 g0 = *(const LAS f32x4*)(lds_gb + col * 4), g1 = *(const LAS f32x4*)(lds_gb + col * 4 + 16), b0 = *(const LAS f32x4*)(lds_gb + 4096 + col * 4), b1 = *(const LAS f32x4*)(lds_gb + 4096 + col * 4 + 16);
#pragma unroll
                for (int m = 0; m < 4; ++m) { const int row = row0 + ai * 128 + m * 16; const u32x4 w = zr[m][bj];
                    const f32x4 z0 = {bf_lo(w.x), bf_hi(w.x), bf_lo(w.y), bf_hi(w.y)}, z1 = {bf_lo(w.z), bf_hi(w.z), bf_lo(w.w), bf_hi(w.w)};
                    const f32x4 x0 = (z0 - mu[m]) * rs[m] * g0 + b0, x1 = (z1 - mu[m]) * rs[m] * g1 + b1;
                    st_bf16x8(zout + (unsigned)(row * DM + col), x0 * ALPHA + acc[ai][bj][m][0] * rb[m], x1 * ALPHA + acc[ai][bj][m][1] * rb[m]); }
            }
            asm volatile("" ::: "memory");
        }
    } else {
#pragma unroll
        for (int ai = 0; ai < 2; ++ai) {
            f32x4 xr[4][2][2]; float rb[4];
#pragma unroll
            for (int m = 0; m < 4; ++m) { const int row = row0 + ai * 128 + m * 16; rb[m] = rsb ? rsb[row] : 1.f;
#pragma unroll
                for (int bj = 0; bj < 2; ++bj) { const float* p = R.x32 + (unsigned)(row * DM + col0 + 128 * bj); xr[m][bj][0] = *(const f32x4*)p; xr[m][bj][1] = *(const f32x4*)(p + 4); } }
#pragma unroll
            for (int m = 0; m < 4; ++m) { const int row = row0 + ai * 128 + m * 16;
#pragma unroll
                for (int bj = 0; bj < 2; ++bj)
                    st_bf16x8(zout + (unsigned)(row * DM + col0 + 128 * bj), xr[m][bj][0] * ALPHA + acc[ai][bj][m][0] * rb[m], xr[m][bj][1] * ALPHA + acc[ai][bj][m][1] * rb[m]); }
            asm volatile("" ::: "memory");
        }
    }
}
struct EpiOut {
    static constexpr bool PERM = true, MID = true;
    ResLn R; bf16_t* out; const float *rsr, *rsb; LAS const unsigned char* lds_gb;
    __device__ __forceinline__ void mid(f32x4 (&acc)[2][2][4][2], const Unit& u, int wr, int wc, int fr, int fq) const {
        const int row0 = u.pm * 256 + wr * 64 + fr;
#pragma unroll
        for (int ai = 0; ai < 2; ++ai)
#pragma unroll
            for (int m = 0; m < 4; ++m) { const float ratio = rsr[row0 + ai * 128 + m * 16];
#pragma unroll
                for (int bj = 0; bj < 2; ++bj)
#pragma unroll
                    for (int n = 0; n < 2; ++n) acc[ai][bj][m][n] *= ratio; }
    }
    __device__ __forceinline__ void operator()(const f32x4 (&acc)[2][2][4][2], const Unit& u, int wr, int wc, int fr, int fq) const {
        resid_epilogue(acc, R, out, rsb, lds_gb, u, wr, wc, fr, fq);
    }
};

struct EpiFfn1 {
    static constexpr bool PERM = true, MID = false;
    bf16_t* O;
    __device__ __forceinline__ void operator()(const f32x4 (&acc)[2][2][4][2], const Unit& u, int wr, int wc, int fr, int fq) const {
        const int row0 = u.pm * 256 + wr * 64 + fr; const int col0 = u.pn * 256 + wc * 32 + 8 * fq;
#pragma unroll
        for (int ai = 0; ai < 2; ++ai)
#pragma unroll
            for (int m = 0; m < 4; ++m) { bf16_t* rowp = O + (unsigned)((row0 + ai * 128 + m * 16) * DFF + col0);
#pragma unroll
                for (int bj = 0; bj < 2; ++bj) { f32x4 v0 = acc[ai][bj][m][0], v1 = acc[ai][bj][m][1];
#pragma unroll
                    for (int e = 0; e < 4; ++e) { const float a = fmaxf(v0[e], 0.f), b = fmaxf(v1[e], 0.f); v0[e] = a * a; v1[e] = b * b; }
                    u32x4 w; w.x = cvtpk(v0[0], v0[1]); w.y = cvtpk(v0[2], v0[3]); w.z = cvtpk(v1[0], v1[1]); w.w = cvtpk(v1[2], v1[3]);
                    *(u32x4*)(rowp + bj * 128) = w; } }
    }
};

struct EpiFfn2 {
    static constexpr bool PERM = true, MID = false;
    ResLn R; bf16_t* X; LAS const unsigned char* lds_gb;
    __device__ __forceinline__ void operator()(const f32x4 (&acc)[2][2][4][2], const Unit& u, int wr, int wc, int fr, int fq) const {
        resid_epilogue(acc, R, X, nullptr, lds_gb, u, wr, wc, fr, fq);
    }
};

__device__ __forceinline__ unsigned f2bf(float f) { unsigned u = __builtin_bit_cast(unsigned, f); return (u + 0x7fffu + ((u >> 16) & 1u)) >> 16; }
__device__ __forceinline__ unsigned pk2(float lo, float hi) { return f2bf(lo) | (f2bf(hi) << 16); }

__device__ __forceinline__ int map_in(int np) {
    const int pn = np >> 8, cc = np & 255, bj = cc >> 7, wc = (cc >> 5) & 3, r = cc & 31;
    if (pn < 4) return 256 * pn + 64 * wc + 32 * bj + r;
    if (pn < 7) return np;
    if (bj == 0) return (wc < 3) ? 1792 + 32 * wc + r : 1920 + r;
    return (wc == 0) ? 1792 + 96 + r : (wc == 3) ? 1920 + 32 + r : -1;
}
__device__ __forceinline__ int map_uq(int np) {
    const int pn = np >> 8, cc = np & 255, bj = cc >> 7, wc = (cc >> 5) & 3, r = cc & 31;
    if (pn < 2) return (2 * pn + bj) * 192 + (cc & 127);
    return wc * 192 + 128 + 32 * bj + r;
}
template <int MAP>
__device__ __forceinline__ void conv_item(const float* __restrict__ W, int K, int N, bf16_t* __restrict__ WT, const float* __restrict__ g0, const float* __restrict__ g1, int ksplit, int nb, int kb, int lane) {
    const int np = 64 * nb + lane, k0 = 64 * kb;
    const int src = (MAP == 1) ? map_in(np) : (MAP == 2) ? map_uq(np) : np;
    const float* wp = W + (size_t)k0 * N + (src >= 0 ? src : 0);
    bf16_t* op = WT + (size_t)np * K + k0;
#pragma unroll
    for (int h = 0; h < 2; ++h) {
        float v[32];
#pragma unroll
        for (int j = 0; j < 32; ++j) v[j] = wp[(size_t)(32 * h + j) * N];
        if (g0) {
#pragma unroll
            for (int j = 0; j < 32; ++j) { const int kx = k0 + 32 * h + j; v[j] *= (kx < ksplit) ? g0[kx] : g1[kx - ksplit]; }
        }
        if (src < 0) {
#pragma unroll
            for (int j = 0; j < 32; ++j) v[j] = 0.f;
        }
#pragma unroll
        for (int c = 0; c < 4; ++c) { u32x4 o; o.x = cvtpk(v[8 * c], v[8 * c + 1]); o.y = cvtpk(v[8 * c + 2], v[8 * c + 3]); o.z = cvtpk(v[8 * c + 4], v[8 * c + 5]); o.w = cvtpk(v[8 * c + 6], v[8 * c + 7]);
            *(u32x4*)(op + 32 * h + 8 * c) = o; }
    }
}

template <bool LITE>
__device__ __forceinline__ void ln_rows(const bf16_t* ZB, float* OUT32, bf16_t* XB, float* MU, float* RS, const float* g, const float* bt, int NGW, int wv) {
    int tid_o = wv * 64 + lane_id(); asm volatile("" : "+v"(tid_o));
    const int lane = tid_o & 63; const int gw = blockIdx.x * 8 + __builtin_amdgcn_readfirstlane(tid_o >> 6);
    const f32x4 g0 = ((const f32x4*)g)[lane], g1 = ((const f32x4*)g)[lane + 64], g2 = ((const f32x4*)g)[lane + 128], g3 = ((const f32x4*)g)[lane + 192];
    const f32x4 b0 = ((const f32x4*)bt)[lane], b1 = ((const f32x4*)bt)[lane + 64], b2 = ((const f32x4*)bt)[lane + 128], b3 = ((const f32x4*)bt)[lane + 192];
    for (int rowb = gw; rowb < T_TOK; rowb += 4 * NGW) {
        u32x2 zr[4][4];
#pragma unroll
        for (int q = 0; q < 4; ++q) { const int row = rowb + q * NGW; if (row < T_TOK) { const u32x2* xr = (const u32x2*)(ZB + (size_t)row * DM) + lane;
#pragma unroll
            for (int j = 0; j < 4; ++j) zr[q][j] = xr[64 * j]; } }
#pragma unroll
        for (int q = 0; q < 4; ++q) { const int row = rowb + q * NGW; if (row < T_TOK) {
            f32x4 v[4]; float s = 0.f;
#pragma unroll
            for (int j = 0; j < 4; ++j) { v[j] = (f32x4){bf_lo(zr[q][j].x), bf_hi(zr[q][j].x), bf_lo(zr[q][j].y), bf_hi(zr[q][j].y)}; s += (v[j][0] + v[j][1]) + (v[j][2] + v[j][3]); }
            const float mean = wave_sum(s) * (1.f / DM); float s2 = 0.f;
#pragma unroll
            for (int j = 0; j < 4; ++j) { v[j] = v[j] - mean; s2 += (v[j][0] * v[j][0] + v[j][1] * v[j][1]) + (v[j][2] * v[j][2] + v[j][3] * v[j][3]); }
            const float rstd = 1.f / sqrtf(wave_sum(s2) * (1.f / DM) + LN_EPS);
            v[0] = v[0] * rstd * g0 + b0; v[1] = v[1] * rstd * g1 + b1; v[2] = v[2] * rstd * g2 + b2; v[3] = v[3] * rstd * g3 + b3;
            if constexpr (LITE) {
                u32x2* o8 = (u32x2*)(XB + (size_t)row * DM) + lane;
#pragma unroll
                for (int j = 0; j < 4; ++j) { u32x2 w; w.x = cvtpk(v[j][0], v[j][1]); w.y = cvtpk(v[j][2], v[j][3]); o8[64 * j] = w; }
                if (lane == 0) { MU[row] = mean; RS[row] = rstd; }
            } else {
                f32x4* xr = (f32x4*)(OUT32 + (size_t)row * DM) + lane;
#pragma unroll
                for (int j = 0; j < 4; ++j) xr[64 * j] = v[j];
            }
        } }
    }
}

#define MFMA32(a, b, c) __builtin_amdgcn_mfma_f32_32x32x16_bf16((a), (b), (c), 0, 0, 0)
constexpr int MLA_KP = 400, MLA_VP = 136, MLA_KBUF = 64 * MLA_KP, MLA_VBUF = 128 * MLA_VP;
__device__ __forceinline__ void mla_unit(LAS char* shm, const bf16_t* __restrict__ QM, const bf16_t* __restrict__ KM, const bf16_t* __restrict__ VM, bf16_t* AO, float* ssB, int b, int h, int qb, int wv) {
    int tid_o = wv * 64 + lane_id(); asm volatile("" : "+v"(tid_o));
    const int tid = tid_o, lane = tid & 63, wid = __builtin_amdgcn_readfirstlane(tid >> 6), r32 = lane & 31, hi = lane >> 5;
    const size_t rowbase = (size_t)b * SEQ; const int q0 = qb * 256; const int NT = (q0 + 256) / 64;
    const int qw = q0 + wid * 32;
    bf16x8 qf[12];
    { const bf16_t* qp = QM + (rowbase + qw + r32) * 768 + h * 192 + hi * 8;
#pragma unroll
      for (int ks = 0; ks < 12; ++ks) qf[ks] = *(const bf16x8*)(qp + ks * 16); }
    int kkey[3], kch[3];
#pragma unroll
    for (int i = 0; i < 3; ++i) { const int id = tid + 512 * i; kkey[i] = id / 24; kch[i] = id % 24; }
    const int vc = 4 * (wid & 3) + (lane & 3), vkp = 16 * (wid >> 2) + (lane >> 2);
    const bf16_t* kg = KM + rowbase * 768 + h * 192; const bf16_t* vg = VM + rowbase * 512 + h * 128 + vc * 8;
    u32x4 kreg[3], vreg[2];
#define MLA_ISSUE(t) do { _Pragma("unroll") for (int i = 0; i < 3; ++i) kreg[i] = *(const u32x4*)(kg + (size_t)((t) * 64 + kkey[i]) * 768 + kch[i] * 8); \
        vreg[0] = *(const u32x4*)(vg + (size_t)((t) * 64 + 2 * vkp) * 512); vreg[1] = *(const u32x4*)(vg + (size_t)((t) * 64 + 2 * vkp + 1) * 512); } while (0)
#define MLA_WRITE(buf) do { LAS char* kb_ = shm + (buf) * MLA_KBUF; _Pragma("unroll") for (int i = 0; i < 3; ++i) *(LAS u32x4*)(kb_ + kkey[i] * MLA_KP + kch[i] * 16) = kreg[i]; \
        LAS char* vb_ = shm + 2 * MLA_KBUF + (buf) * MLA_VBUF + (8 * vc) * MLA_VP + 4 * vkp; \
        _Pragma("unroll") for (int j = 0; j < 4; ++j) { const unsigned a_ = vreg[0][j], b_ = vreg[1][j]; \
            *(LAS unsigned*)(vb_ + (2 * j) * MLA_VP) = (a_ & 0xffffu) | (b_ << 16); *(LAS unsigned*)(vb_ + (2 * j + 1) * MLA_VP) = (a_ >> 16) | (b_ & 0xffff0000u); } } while (0)
    f32x16 o[4];
#pragma unroll
    for (int d = 0; d < 4; ++d) o[d] = f32x16{};
    float mrun = -1e30f, lrun = 0.f;
    MLA_ISSUE(0); MLA_WRITE(0); __syncthreads();
    for (int t = 0; t < NT; ++t) {
        const int cur = t & 1;
        if (t + 1 < NT) MLA_ISSUE(t + 1);
        if (t * 64 <= qw + 31) {
            f32x16 s0 = f32x16{}, s1 = f32x16{};
            { const LAS char* kb = shm + cur * MLA_KBUF + r32 * MLA_KP + hi * 16;
              bf16x8 ka[2][6];
#pragma unroll
              for (int i = 0; i < 3; ++i) { ka[0][2 * i] = *(const LAS bf16x8*)(kb + i * 32); ka[0][2 * i + 1] = *(const LAS bf16x8*)(kb + 32 * MLA_KP + i * 32); }
              __builtin_amdgcn_sched_barrier(0);
#pragma unroll
              for (int bt = 0; bt < 4; ++bt) {
                  if (bt < 3) {
#pragma unroll
                      for (int i = 0; i < 3; ++i) { ka[(bt + 1) & 1][2 * i] = *(const LAS bf16x8*)(kb + (3 * (bt + 1) + i) * 32); ka[(bt + 1) & 1][2 * i + 1] = *(const LAS bf16x8*)(kb + 32 * MLA_KP + (3 * (bt + 1) + i) * 32); }
                  }
                  __builtin_amdgcn_sched_barrier(0);
#pragma unroll
                  for (int i = 0; i < 3; ++i) { s0 = MFMA32(ka[bt & 1][2 * i], qf[3 * bt + i], s0); s1 = MFMA32(ka[bt & 1][2 * i + 1], qf[3 * bt + i], s1); }
                  __builtin_amdgcn_sched_barrier(0);
              } }
            if (t * 64 + 63 > qw) {
                const int qq = qw + r32;
#pragma unroll
                for (int r = 0; r < 16; ++r) { const int kv = t * 64 + crow(r, hi); if (kv > qq) s0[r] = -INFINITY; if (kv + 32 > qq) s1[r] = -INFINITY; }
            }
            float mx = fmaxf(s0[0], s1[0]);
#pragma unroll
            for (int r = 1; r < 16; ++r) mx = fmaxf(mx, fmaxf(s0[r], s1[r]));
            mx = xmax32(mx);
            const float mnew = fmaxf(mrun, mx); const float alpha = __builtin_amdgcn_exp2f(mrun - mnew); mrun = mnew;
            float ps = 0.f;
#pragma unroll
            for (int r = 0; r < 16; ++r) { s0[r] = __builtin_amdgcn_exp2f(s0[r] - mnew); s1[r] = __builtin_amdgcn_exp2f(s1[r] - mnew); ps += s0[r] + s1[r]; }
            lrun = lrun * alpha + ps;
#pragma unroll
            for (int d = 0; d < 4; ++d) o[d] *= alpha;
            u32x4 pw[4];
#pragma unroll
            for (int j = 0; j < 4; ++j) { pw[0][j] = cvtpk(s0[2 * j], s0[2 * j + 1]); pw[1][j] = cvtpk(s0[8 + 2 * j], s0[9 + 2 * j]); pw[2][j] = cvtpk(s1[2 * j], s1[2 * j + 1]); pw[3][j] = cvtpk(s1[8 + 2 * j], s1[9 + 2 * j]); }
            { const LAS char* vb = shm + 2 * MLA_KBUF + cur * MLA_VBUF + r32 * MLA_VP + hi * 8;
              u32x2 vlo[2][4], vhi[2][4];
#pragma unroll
              for (int d = 0; d < 4; ++d) { vlo[0][d] = *(const LAS u32x2*)(vb + d * 32 * MLA_VP); vhi[0][d] = *(const LAS u32x2*)(vb + d * 32 * MLA_VP + 16); }
              __builtin_amdgcn_sched_barrier(0);
#pragma unroll
              for (int j = 0; j < 4; ++j) {
                  if (j < 3) {
#pragma unroll
                      for (int d = 0; d < 4; ++d) { vlo[(j + 1) & 1][d] = *(const LAS u32x2*)(vb + d * 32 * MLA_VP + (j + 1) * 32); vhi[(j + 1) & 1][d] = *(const LAS u32x2*)(vb + d * 32 * MLA_VP + (j + 1) * 32 + 16); }
                  }
                  __builtin_amdgcn_sched_barrier(0);
#pragma unroll
                  for (int d = 0; d < 4; ++d) { const u32x4 va = {vlo[j & 1][d].x, vlo[j & 1][d].y, vhi[j & 1][d].x, vhi[j & 1][d].y};
                      o[d] = MFMA32(__builtin_bit_cast(bf16x8, va), __builtin_bit_cast(bf16x8, pw[j]), o[d]); }
                  __builtin_amdgcn_sched_barrier(0);
              } }
        }
        if (t + 1 < NT) MLA_WRITE(cur ^ 1);
        __syncthreads();
    }
#undef MLA_ISSUE
#undef MLA_WRITE
    lrun = xadd32(lrun);
    const float inv = 1.f / lrun; float ss = 0.f;
    const size_t row = rowbase + qw + r32;
    LAS char* ot = shm + wid * 8704;
#pragma unroll
    for (int d = 0; d < 4; ++d)
#pragma unroll
        for (int g = 0; g < 4; ++g) { const f32x4 v = {o[d][4 * g] * inv, o[d][4 * g + 1] * inv, o[d][4 * g + 2] * inv, o[d][4 * g + 3] * inv};
            ss += (v[0] * v[0] + v[1] * v[1]) + (v[2] * v[2] + v[3] * v[3]);
            u32x2 w; w.x = cvtpk(v[0], v[1]); w.y = cvtpk(v[2], v[3]); *(LAS u32x2*)(ot + r32 * 272 + (32 * d + 8 * g + 4 * hi) * 2) = w; }
    ss = xadd32(ss);
    if (hi == 0) ssB[row * 4 + h] = ss;
    asm volatile("s_waitcnt lgkmcnt(0)" ::: "memory");
    { const int rr = lane >> 4, ch = lane & 15;
      bf16_t* ob = AO + (rowbase + qw) * 1024 + 512 + h * 128 + ch * 8;
#pragma unroll
      for (int i = 0; i < 8; ++i) { const int ri = 4 * i + rr; *(u32x4*)(ob + (size_t)ri * 1024) = *(const LAS u32x4*)(ot + ri * 272 + ch * 16); } }
    asm volatile("s_waitcnt lgkmcnt(0)" ::: "memory");
    __syncthreads();
}

constexpr int BD_KP = 144, BD_VP = 776, BD_KBYTES = 384 * BD_KP, BD_VBYTES = 64 * BD_VP;
struct BandUnit { int b, head, d, rho, blk, pidx; };
template <bool FINAL> __device__ __forceinline__ BandUnit band_decode(int u) {
    BandUnit r;
    if constexpr (FINAL) { r.b = u >> 7; r.head = (u >> 4) & 7; r.d = 1; r.rho = 0; r.blk = u & 15; r.pidx = 0; }
    else if (u < 1024) { r.b = u >> 7; r.head = (u >> 4) & 7; r.d = 16; r.rho = u & 15; r.blk = 0; r.pidx = 0; }
    else { const int v = u - 1024; r.b = v >> 7; r.head = (v >> 4) & 7; r.d = 4; r.rho = (v >> 2) & 3; r.blk = v & 3; r.pidx = 1; }
    return r;
}
template <bool FINAL>
__device__ __forceinline__ void band_phase(LAS char* shm, const bf16_t* __restrict__ QA, const bf16_t* __restrict__ KA, const bf16_t* __restrict__ VA,
                                           bf16_t* OP, float* LSE, bf16_t* AO, float* ssA, int first, int nunits, int stride, int wv) {
    int tid_o = wv * 64 + lane_id(); asm volatile("" : "+v"(tid_o));
    const int tid = tid_o, lane = tid & 63, wid = __builtin_amdgcn_readfirstlane(tid >> 6), r32 = lane & 31, hi = lane >> 5;
    const int kk = tid >> 3, c8 = tid & 7;
    u32x4 kreg[6], vreg[3][2];
#define BD_ISSUE(U) do { const unsigned rb_ = (unsigned)(U).b * SEQ + (U).rho; const int p0_ = (U).blk * 256 - 128; const int k0_ = ((U).blk == 0) ? 2 : 0; \
        const bf16_t* kg_ = KA + (unsigned)(rb_ * 512 + (U).head * 64 + c8 * 8); const bf16_t* vg_ = VA + (unsigned)(rb_ * 512 + (U).head * 64 + c8 * 8); \
        _Pragma("unroll") for (int i = 0; i < 6; ++i) if (i >= k0_) kreg[i] = *(const u32x4*)(kg_ + (unsigned)((U).d * (p0_ + 64 * i + kk) * 512)); \
        _Pragma("unroll") for (int i = 0; i < 3; ++i) if (2 * i + 1 >= k0_) { const int kp_ = p0_ + 2 * (kk + 64 * i); \
            vreg[i][0] = *(const u32x4*)(vg_ + (unsigned)((U).d * kp_ * 512)); vreg[i][1] = *(const u32x4*)(vg_ + (unsigned)((U).d * (kp_ + 1) * 512)); } } while (0)
#define BD_WRITE(U) do { const int k0_ = ((U).blk == 0) ? 2 : 0; \
        _Pragma("unroll") for (int i = 0; i < 6; ++i) if (i >= k0_) *(LAS u32x4*)(shm + (64 * i + kk) * BD_KP + c8 * 16) = kreg[i]; \
        _Pragma("unroll") for (int i = 0; i < 3; ++i) if (2 * i + 1 >= k0_) { LAS char* vb_ = shm + BD_KBYTES + (8 * c8) * BD_VP + 4 * (kk + 64 * i); \
            _Pragma("unroll") for (int j = 0; j < 4; ++j) { const unsigned a_ = vreg[i][0][j], b_ = vreg[i][1][j]; \
                *(LAS unsigned*)(vb_ + (2 * j) * BD_VP) = (a_ & 0xffffu) | (b_ << 16); *(LAS unsigned*)(vb_ + (2 * j + 1) * BD_VP) = (a_ >> 16) | (b_ & 0xffff0000u); } } } while (0)
    int u = first; asm volatile("" : "+s"(u));
    BandUnit U = band_decode<FINAL>(u);
    BD_ISSUE(U);
    for (;;) {
        const int b = U.b, head = U.head, d = U.d, rho = U.rho, blk = U.blk, pidx = U.pidx;
        const unsigned rowbase = (unsigned)b * SEQ; const int P0 = blk * 256;
        const unsigned row = rowbase + rho + d * (P0 + wid * 32 + r32);
        bf16x8 qf[4];
        { const bf16_t* qp = QA + (unsigned)(row * 512 + head * 64 + hi * 8);
#pragma unroll
          for (int ks = 0; ks < 4; ++ks) qf[ks] = *(const bf16x8*)(qp + ks * 16); }
        BD_WRITE(U);
        __syncthreads();
        const int un = u + stride; const bool has_next = un < nunits;
        if (has_next) { U = band_decode<FINAL>(un); BD_ISSUE(U); }
        f32x16 o[2]; o[0] = f32x16{}; o[1] = f32x16{};
        float mrun = -1e30f, lrun = 0.f;
        const int k0 = (blk == 0) ? 2 : 0;
#pragma unroll 1
        for (int kap = k0; kap < 6; ++kap) {
            if (64 * kap >= 32 * wid - 63 && 64 * kap <= 32 * wid + 159) {
                f32x16 s0 = f32x16{}, s1 = f32x16{};
                { const LAS char* kb = shm + (64 * kap + r32) * BD_KP + hi * 16;
#pragma unroll
                  for (int ks = 0; ks < 4; ++ks) { const bf16x8 a0 = *(const LAS bf16x8*)(kb + ks * 32), a1 = *(const LAS bf16x8*)(kb + 32 * BD_KP + ks * 32);
                      s0 = MFMA32(a0, qf[ks], s0); s1 = MFMA32(a1, qf[ks], s1); } }
                { const int qrel = 32 * wid + r32; const int kb0 = 64 * kap - 128;
#pragma unroll
                  for (int r = 0; r < 16; ++r) { const int kr = kb0 + crow(r, hi); const int dist0 = qrel - kr, dist1 = dist0 - 32;
                      if (dist0 < 0 || dist0 > 128) s0[r] = -INFINITY; if (dist1 < 0 || dist1 > 128) s1[r] = -INFINITY; } }
                float mx = fmaxf(s0[0], s1[0]);
#pragma unroll
                for (int r = 1; r < 16; ++r) mx = fmaxf(mx, fmaxf(s0[r], s1[r]));
                mx = xmax32(mx);
                const float mnew = fmaxf(mrun, mx); const float alpha = __builtin_amdgcn_exp2f(mrun - mnew); mrun = mnew;
                float ps = 0.f;
#pragma unroll
                for (int r = 0; r < 16; ++r) { s0[r] = __builtin_amdgcn_exp2f(s0[r] - mnew); s1[r] = __builtin_amdgcn_exp2f(s1[r] - mnew); ps += s0[r] + s1[r]; }
                lrun = lrun * alpha + ps;
                o[0] *= alpha; o[1] *= alpha;
                u32x4 pw[4];
#pragma unroll
                for (int j = 0; j < 4; ++j) { pw[0][j] = cvtpk(s0[2 * j], s0[2 * j + 1]); pw[1][j] = cvtpk(s0[8 + 2 * j], s0[9 + 2 * j]); pw[2][j] = cvtpk(s1[2 * j], s1[2 * j + 1]); pw[3][j] = cvtpk(s1[8 + 2 * j], s1[9 + 2 * j]); }
                { const LAS char* vb = shm + BD_KBYTES + r32 * BD_VP + 128 * kap + hi * 8;
#pragma unroll
                  for (int dd = 0; dd < 2; ++dd)
#pragma unroll
                    for (int j = 0; j < 4; ++j) { const u32x2 lo = *(const LAS u32x2*)(vb + dd * 32 * BD_VP + j * 32), hh = *(const LAS u32x2*)(vb + dd * 32 * BD_VP + j * 32 + 16);
                        const u32x4 va = {lo.x, lo.y, hh.x, hh.y};
                        o[dd] = MFMA32(__builtin_bit_cast(bf16x8, va), __builtin_bit_cast(bf16x8, pw[j]), o[dd]); } }
            }
        }
        __syncthreads();
        lrun = xadd32(lrun);
        LAS char* ot = shm + wid * 9216;
        {
            float c3, c1 = 0.f, c2 = 0.f;
            if constexpr (!FINAL) { c3 = 1.f / lrun; if (hi == 0) LSE[(size_t)pidx * T_TOK * 8 + (unsigned)(row * 8 + head)] = mrun + __builtin_amdgcn_logf(lrun); }
            else {
                const float l1 = LSE[(unsigned)(row * 8 + head)], l2 = LSE[(size_t)T_TOK * 8 + (unsigned)(row * 8 + head)];
                const float M = fmaxf(mrun, fmaxf(l1, l2));
                const float w3 = __builtin_amdgcn_exp2f(mrun - M), w1 = __builtin_amdgcn_exp2f(l1 - M), w2 = __builtin_amdgcn_exp2f(l2 - M);
                const float inv = 1.f / (lrun * w3 + w1 + w2);
                c3 = w3 * inv; c1 = w1 * inv; c2 = w2 * inv;
            }
            if (hi == 0) *(LAS f32x4*)(ot + 8704 + r32 * 16) = (f32x4){c3, c1, c2, 0.f};
#pragma unroll
            for (int dd = 0; dd < 2; ++dd)
#pragma unroll
                for (int g = 0; g < 4; ++g) *(LAS f32x4*)(ot + r32 * 272 + (32 * dd + 8 * g + 4 * hi) * 4) = (f32x4){o[dd][4 * g], o[dd][4 * g + 1], o[dd][4 * g + 2], o[dd][4 * g + 3]};
        }
        asm volatile("s_waitcnt lgkmcnt(0)" ::: "memory");
        {
            const int rr = lane >> 4, ch = lane & 15;
            const unsigned rowq0 = rowbase + rho + d * (P0 + wid * 32);
#pragma unroll
            for (int i = 0; i < 8; ++i) {
                const int ri = 4 * i + rr; const unsigned rowg = rowq0 + d * ri;
                const f32x4 v = *(const LAS f32x4*)(ot + ri * 272 + ch * 16), cc = *(const LAS f32x4*)(ot + 8704 + ri * 16);
                if constexpr (!FINAL) {
                    st_bf16x4(OP + (size_t)pidx * T_TOK * 512 + (unsigned)(rowg * 512 + head * 64 + ch * 4), v * cc[0]);
                } else {
                    const u32x2 a = *(const u32x2*)(OP + (unsigned)(rowg * 512 + head * 64 + ch * 4)), bb = *(const u32x2*)(OP + (size_t)T_TOK * 512 + (unsigned)(rowg * 512 + head * 64 + ch * 4));
                    const f32x4 w = {v[0] * cc[0] + bf_lo(a.x) * cc[1] + bf_lo(bb.x) * cc[2], v[1] * cc[0] + bf_hi(a.x) * cc[1] + bf_hi(bb.x) * cc[2],
                                     v[2] * cc[0] + bf_lo(a.y) * cc[1] + bf_lo(bb.y) * cc[2], v[3] * cc[0] + bf_hi(a.y) * cc[1] + bf_hi(bb.y) * cc[2]};
                    st_bf16x4(AO + (unsigned)(rowg * 1024 + head * 64 + ch * 4), w);
                    float ss = (w[0] * w[0] + w[1] * w[1]) + (w[2] * w[2] + w[3] * w[3]);
                    ss += swz_xor<1>(ss); ss += swz_xor<2>(ss); ss += swz_xor<4>(ss); ss += swz_xor<8>(ss);
                    if (ch == 0) ssA[(unsigned)(rowg * 8 + head)] = ss;
                }
            }
        }
        __syncthreads();
        if (!has_next) break;
        u = un;
    }
#undef BD_ISSUE
#undef BD_WRITE
}

#define XB_TMO      128
#define XB_XCNT(j)  (256  + 64 * (j))
#define XB_XSUB(j)  (1280 + 64 * (j))
#define XB_XGEN(j)  (2304 + 64 * (j))
#define XB_TOP      3328
#define XB_TOPGEN   3392
#define XCD_BAR_WORDS 3456
#define XB_SPIN_CAP (1u << 18)
__device__ __forceinline__ unsigned xb_ld(unsigned* p)              { return __hip_atomic_load(p, __ATOMIC_RELAXED, __HIP_MEMORY_SCOPE_AGENT); }
__device__ __forceinline__ unsigned xb_add(unsigned* p, unsigned v) { return __hip_atomic_fetch_add(p, v, __ATOMIC_RELAXED, __HIP_MEMORY_SCOPE_AGENT); }
__device__ __forceinline__ unsigned xb_xcc_id() { return (unsigned)__builtin_amdgcn_s_getreg((3 << 11) | 20) & 0xFu; }
#define XB_SPIN(cond, bar) do { unsigned _sp = 0; while (cond) { __builtin_amdgcn_s_sleep(1); \
    if ((++_sp & 255u) == 0u) { if (xb_ld(&(bar)[XB_TMO])) break; if (_sp > XB_SPIN_CAP) { atomicAdd(&(bar)[XB_TMO], 1u); break; } } } } while (0)
struct XcdBarrier { unsigned* bar; unsigned x; volatile LAS unsigned* st; int wv; };
__device__ __forceinline__ XcdBarrier xcd_barrier_post(unsigned* bar, volatile LAS unsigned* st, int wv) {
    XcdBarrier b; b.bar = bar; b.x = xb_xcc_id(); b.st = st; b.wv = wv;
    if (wv == 0 && lane_id() == 0) (void)xb_add(&bar[XB_XCNT(b.x)], 1u);
    return b;
}
__device__ __forceinline__ void xcd_barrier_complete(unsigned* bar, unsigned x, unsigned& nloc, unsigned& nx) {
    const unsigned G = gridDim.x * gridDim.y * gridDim.z;
    unsigned sum, cnt, mine, sp = 0u;
    for (;;) {
        sum = 0u; cnt = 0u; mine = 0u;
#pragma unroll
        for (unsigned j = 0; j < 16; ++j) { const unsigned c = xb_ld(&bar[XB_XCNT(j)]); sum += c; cnt += (c > 0u) ? 1u : 0u; mine = (j == x) ? c : mine; }
        if (sum == G) break;
        __builtin_amdgcn_s_sleep(1);
        if ((++sp & 255u) == 0u) { if (xb_ld(&bar[XB_TMO])) break; if (sp > XB_SPIN_CAP) { atomicAdd(&bar[XB_TMO], 1u); break; } }
    }
    nloc = mine > 0u ? mine : 1u; nx = cnt > 0u ? cnt : 1u;
}
__device__ __forceinline__ void xcd_barrier(const XcdBarrier& b) {
    asm volatile("s_waitcnt vmcnt(0)" ::: "memory");
    __syncthreads();
    if (b.wv == 0 && lane_id() == 0) {
        unsigned* bar = b.bar;
        __builtin_amdgcn_s_waitcnt(0);
        unsigned nloc = b.st[0], nx = b.st[1];
        if (nloc == 0u) { xcd_barrier_complete(bar, b.x, nloc, nx); b.st[0] = nloc; b.st[1] = nx; }
        const unsigned old = xb_add(&bar[XB_XSUB(b.x)], 1u);
        const unsigned gen = old / nloc;
        if (old + 1u == (gen + 1u) * nloc) {
            __builtin_amdgcn_fence(__ATOMIC_RELEASE, "agent");
            asm volatile("s_waitcnt vmcnt(0)" ::: "memory");
            const unsigned og = xb_add(&bar[XB_TOP], 1u);
            const unsigned tg = og / nx;
            if (og + 1u == (tg + 1u) * nx) xb_add(&bar[XB_TOPGEN], 1u);
            else XB_SPIN(xb_ld(&bar[XB_TOPGEN]) == tg, bar);
            __builtin_amdgcn_fence(__ATOMIC_ACQUIRE, "agent");
            xb_add(&bar[XB_XGEN(b.x)], 1u);
            asm volatile("s_waitcnt vmcnt(0)" ::: "memory");
        } else {
            XB_SPIN(xb_ld(&bar[XB_XGEN(b.x)]) == gen, bar);
            __builtin_amdgcn_fence(__ATOMIC_ACQUIRE, "agent");
            asm volatile("s_waitcnt vmcnt(0)" ::: "memory");
        }
    }
    __syncthreads();
}

struct Args { const float* in[15]; float* out; unsigned char* ws; };
typedef const __attribute__((address_space(4))) unsigned char* kptr_t;
#define KA_PTR(idx) ({ kptr_t p_ = (kptr_t)__builtin_amdgcn_kernarg_segment_ptr(); asm volatile("" : "+s"(p_)); *(const __attribute__((address_space(4))) unsigned long long*)(p_ + 8 * (idx)); })
#define GASP __attribute__((address_space(1)))
#define K_IN(idx) ((const float*)(const GASP float*)KA_PTR(idx))
#define K_OUT() ((float*)(GASP float*)KA_PTR(15))
#define K_WS() ((unsigned char*)(GASP unsigned char*)KA_PTR(16))

#define W_BASE(L) (((L) == 0) ? (K_WS() + WS_W) : ((unsigned char*)K_OUT() + (size_t)((L) - 1) * W_LAYER_BYTES))
#define CONV_ALL() do { \
        int tid_ = wv * 64 + lane_id(); asm volatile("" : "+v"(tid_)); const int lane_ = tid_ & 63, gw_ = bx * 8 + wv; \
        constexpr int I_IN = (IN_PAD / 64) * (DM / 64), I_UQ = (768 / 64) * (256 / 64), I_UKV = (1024 / 64) * (128 / 64), I_O = (DM / 64) * (DM / 64), I_1 = (DFF / 64) * (DM / 64), I_2 = (DM / 64) * (DFF / 64); \
        constexpr int I_LAYER = I_IN + I_UQ + I_UKV + I_O + I_1 + I_2; \
        _Pragma("unroll 1") for (int it = gw_; it < DEPTH * I_LAYER; it += NGW) { const int l_ = it / I_LAYER; int r = it - l_ * I_LAYER; unsigned char* wl = W_BASE(l_); \
            if (r < I_IN) { conv_item<1>(K_IN(1) + (size_t)l_ * DM * IN_COLS, DM, IN_COLS, (bf16_t*)(wl + WO_IN), nullptr, nullptr, 0, r / (DM / 64), r % (DM / 64), lane_); continue; } r -= I_IN; \
            if (r < I_UQ) { conv_item<2>(K_IN(4) + (size_t)l_ * 256 * 768, 256, 768, (bf16_t*)(wl + WO_UQ), K_IN(2) + l_ * 256, K_IN(2) + l_ * 256, 256, r / 4, r % 4, lane_); continue; } r -= I_UQ; \
            if (r < I_UKV) { conv_item<0>(K_IN(5) + (size_t)l_ * 128 * 1024, 128, 1024, (bf16_t*)(wl + WO_UKV), K_IN(3) + l_ * 128, K_IN(3) + l_ * 128, 128, r / 2, r % 2, lane_); continue; } r -= I_UKV; \
            if (r < I_O) { conv_item<0>(K_IN(8) + (size_t)l_ * DM * DM, DM, DM, (bf16_t*)(wl + WO_O), K_IN(6) + l_ * 512, K_IN(7) + l_ * 512, 512, r / (DM / 64), r % (DM / 64), lane_); continue; } r -= I_O; \
            if (r < I_1) { conv_item<0>(K_IN(11) + (size_t)l_ * DM * DFF, DM, DFF, (bf16_t*)(wl + WO_1), nullptr, nullptr, 0, r / (DM / 64), r % (DM / 64), lane_); continue; } r -= I_1; \
            conv_item<0>(K_IN(12) + (size_t)l_ * DFF * DM, DFF, DM, (bf16_t*)(wl + WO_2), nullptr, nullptr, 0, r / (DFF / 64), r % (DFF / 64), lane_); } } while (0)

__global__ void __launch_bounds__(512, 2) fwd_mega(Args args_unused) {
    extern __shared__ __attribute__((aligned(16))) unsigned char lds_raw[];
    LAS unsigned char* lds = (LAS unsigned char*)lds_raw;
    cg::grid_group grid = cg::this_grid();
    const int G = gridDim.x, bx = blockIdx.x;
    const int NGW = G * 8;
    const int wv = __builtin_amdgcn_readfirstlane(threadIdx.x >> 6);

    volatile LAS unsigned* bst = (volatile LAS unsigned*)(lds + 131072 + 512);
    if (wv == 0 && lane_id() < 2) bst[lane_id()] = 0u;
    __syncthreads();
    XcdBarrier xbar = xcd_barrier_post((unsigned*)K_WS(), bst, wv);
#if USE_XCD_BARRIER
#define GRID_SYNC() xcd_barrier(xbar)
#else
#define GRID_SYNC() grid.sync()
#endif

    if (PH_MASK & 1) {
        int tid = wv * 64 + lane_id(); asm volatile("" : "+v"(tid)); const int lane = tid & 63, wave = wv, gw = bx * 8 + wave;
        unsigned char* ws = K_WS();
        float* cs = (float*)(ws + WS_ROPE);
        for (int idx = bx * 512 + tid; idx < SEQ * 32; idx += G * 512) {
            const int pos = idx >> 5, i = idx & 31;
            double f = 1.0; for (int k = 0; k < i; ++k) f *= 0.74989420933245583;
            const double ang = (double)pos * f;
            const double kk = __builtin_rint(ang * 0.15915494309189535);
            const double r = ang - kk * 6.283185307179586477;
            const double r2 = r * r;
            double sn = 1.0, cn = 1.0;
#pragma unroll 1
            for (int n = 14; n >= 1; --n) { sn = 1.0 - sn * r2 / (double)((2 * n) * (2 * n + 1)); cn = 1.0 - cn * r2 / (double)((2 * n - 1) * (2 * n)); }
            cs[idx] = (float)cn; cs[SEQ * 32 + idx] = (float)(sn * r);
        }
        CONV_ALL();
        const float* x_in = K_IN(0); bf16_t* XB = (bf16_t*)(ws + WS_XB);
        for (unsigned i = (unsigned)bx * 512 + tid; i < (unsigned)(T_TOK * DM / 8); i += (unsigned)G * 512) {
            const f32x4 a = ((const f32x4*)x_in)[2 * i], b = ((const f32x4*)x_in)[2 * i + 1];
            u32x4 w; w.x = cvtpk(a[0], a[1]); w.y = cvtpk(a[2], a[3]); w.z = cvtpk(b[0], b[1]); w.w = cvtpk(b[2], b[3]);
            ((u32x4*)XB)[i] = w;
        }
    }
    grid.sync();

#pragma unroll 1
    for (int l = 0; l < DEPTH; ++l) {
        for (int rep_ = 0; rep_ < ((DUP_MASK & 2) ? 2 : 1); ++rep_) if (PH_MASK & 2) {
            unsigned char* ws = K_WS(); unsigned char* wl = W_BASE(l);
            pg8::Gemm g{(const bf16_t*)(ws + WS_XB), (const bf16_t*)(wl + WO_IN), T_TOK, IN_PAD, DM}; pg8::StaticOrder S; S.init(T_TOK, IN_PAD, G, bx);
            EpiIn E{(bf16_t*)(ws + WS_QA), (bf16_t*)(ws + WS_KA), (bf16_t*)(ws + WS_VA), (bf16_t*)(ws + WS_CQ), (bf16_t*)(ws + WS_CKV), (bf16_t*)(ws + WS_KM),
                    (float*)(ws + WS_PCQ), (float*)(ws + WS_PCKV), (const float*)(ws + WS_ROPE)};
            pg8::gemm_phase<EpiIn, pg8::StaticOrder, true, true>(lds, g, S, E, wv);
        }
        GRID_SYNC();
        for (int rep_ = 0; rep_ < ((DUP_MASK & 4) ? 2 : 1); ++rep_) if (PH_MASK & 4) {
            unsigned char* ws = K_WS(); unsigned char* wl = W_BASE(l);
            float* rsq = (float*)(ws + WS_RSQ); const float* pcq = (const float*)(ws + WS_PCQ);
            pg8::Gemm g{(const bf16_t*)(ws + WS_CQ), (const bf16_t*)(wl + WO_UQ), T_TOK, 768, 256}; pg8::StaticOrder S; S.init(T_TOK, 768, G, bx);
            { int tid = wv * 64 + lane_id(); asm volatile("" : "+v"(tid)); Unit u; for (int i = 0; S.next(i, u); ++i) if (tid < 256) { const int row = u.pm * 256 + tid; const f32x4 pp = *(const f32x4*)(pcq + row * 4);
                  rsq[row] = QSCALE_M / sqrtf(((pp[0] + pp[1]) + (pp[2] + pp[3])) * (1.f / 256.f) + RMS_EPS); } }
            __syncthreads();
            EpiUpQ E{(bf16_t*)(ws + WS_QM), rsq, (const float*)(ws + WS_ROPE)};
            pg8::gemm_phase<EpiUpQ, pg8::StaticOrder, true, true>(lds, g, S, E, wv);
        }
        for (int rep_ = 0; rep_ < ((DUP_MASK & 8) ? 2 : 1); ++rep_) if (PH_MASK & 8) {
            unsigned char* ws = K_WS(); unsigned char* wl = W_BASE(l);
            float* rskv = (float*)(ws + WS_RSKV); const float* pckv = (const float*)(ws + WS_PCKV);
            pg8::Gemm g{(const bf16_t*)(ws + WS_CKV), (const bf16_t*)(wl + WO_UKV), T_TOK, 1024, 128}; pg8::StaticOrder S; S.init(T_TOK, 1024, G, bx);
            { int tid = wv * 64 + lane_id(); asm volatile("" : "+v"(tid)); Unit u; for (int i = 0; S.next(i, u); ++i) if (tid < 256) { const int row = u.pm * 256 + tid; const f32x4 pp = *(const f32x4*)(pckv + row * 4);
                  rskv[row] = 1.f / sqrtf(((pp[0] + pp[1]) + (pp[2] + pp[3])) * (1.f / 128.f) + RMS_EPS); } }
            __syncthreads();
            EpiUpKV E{(bf16_t*)(ws + WS_KM), (bf16_t*)(ws + WS_VM), rskv};
            pg8::gemm_phase<EpiUpKV, pg8::StaticOrder, true, true>(lds, g, S, E, wv);
        }
        for (int rep_ = 0; rep_ < ((DUP_MASK & 1024) ? 2 : 1); ++rep_) if (PH_MASK & 32) {
            unsigned char* ws = K_WS();
            band_phase<false>((LAS char*)lds, (const bf16_t*)(ws + WS_QA), (const bf16_t*)(ws + WS_KA), (const bf16_t*)(ws + WS_VA), (bf16_t*)(ws + WS_XB), (float*)(ws + WS_LSE),
                              nullptr, nullptr, bx, 2048, G, wv);
            __syncthreads();
        }
        GRID_SYNC();
#pragma unroll 1
        for (int step = 0; step < 2; ++step) {
            const bool do_mla = (step == 0) != (((bx >> 7) & 1) != 0);
            if (do_mla) {
                unsigned char* ws = K_WS();
                const int vb = (G % 8 == 0) ? (bx % 8) * (G / 8) + bx / 8 : bx;
                for (int p = vb; p < 256; p += G) {
                    const int bh = p >> 3, s = p & 7;
                    mla_unit((LAS char*)lds, (const bf16_t*)(ws + WS_QM), (const bf16_t*)(ws + WS_KM), (const bf16_t*)(ws + WS_VM), (bf16_t*)(ws + WS_AO), (float*)(ws + WS_SSB), bh >> 2, bh & 3, 15 - s, wv);
                    mla_unit((LAS char*)lds, (const bf16_t*)(ws + WS_QM), (const bf16_t*)(ws + WS_KM), (const bf16_t*)(ws + WS_VM), (bf16_t*)(ws + WS_AO), (float*)(ws + WS_SSB), bh >> 2, bh & 3, s, wv);
                }
            } else {
                unsigned char* ws = K_WS();
                band_phase<true>((LAS char*)lds, (const bf16_t*)(ws + WS_QA), (const bf16_t*)(ws + WS_KA), (const bf16_t*)(ws + WS_VA), (bf16_t*)(ws + WS_XB), (float*)(ws + WS_LSE),
                                 (bf16_t*)(ws + WS_AO), (float*)(ws + WS_SSA), bx, 1024, G, wv);
                __syncthreads();
            }
        }
        GRID_SYNC();
        if (PH_MASK & 64) {
            unsigned char* ws = K_WS(); unsigned char* wl = W_BASE(l);
            bf16_t* out = (bf16_t*)(ws + WS_ZB);
            ResLn R; R.ln = (l > 0); R.x32 = K_IN(0); R.zb = (const bf16_t*)out; R.mu = (const float*)(ws + WS_MU2); R.rs = (const float*)(ws + WS_RS2);
            { const float* gsrc = K_IN(13) + (l > 0 ? l - 1 : 0) * DM; const float* bsrc = K_IN(14) + (l > 0 ? l - 1 : 0) * DM; const int t_ = wv * 64 + lane_id();
              ((LAS float*)(lds + LDS_GB_OFF))[t_] = gsrc[t_]; ((LAS float*)(lds + LDS_GB_OFF))[t_ + 512] = gsrc[t_ + 512];
              ((LAS float*)(lds + LDS_GB_OFF + 4096))[t_] = bsrc[t_]; ((LAS float*)(lds + LDS_GB_OFF + 4096))[t_ + 512] = bsrc[t_ + 512]; }
            float* rsr = (float*)(ws + WS_RSR); float* rsbv = (float*)(ws + WS_RSB); const float* ssA = (const float*)(ws + WS_SSA); const float* ssB = (const float*)(ws + WS_SSB);
            pg8::Gemm g{(const bf16_t*)(ws + WS_AO), (const bf16_t*)(wl + WO_O), T_TOK, DM, DM}; pg8::StaticOrder S; S.init(T_TOK, DM, G, bx);
            { int tid = wv * 64 + lane_id(); asm volatile("" : "+v"(tid)); Unit u; for (int i = 0; S.next(i, u); ++i) if (tid < 256) { const int row = u.pm * 256 + tid;
                  const f32x4 a = *(const f32x4*)(ssA + row * 8), b = *(const f32x4*)(ssA + row * 8 + 4), c = *(const f32x4*)(ssB + row * 4);
                  const float ra = 1.f / sqrtf((((a[0] + a[1]) + (a[2] + a[3])) + ((b[0] + b[1]) + (b[2] + b[3]))) * (1.f / 512.f) + RMS_EPS);
                  const float rb = 1.f / sqrtf(((c[0] + c[1]) + (c[2] + c[3])) * (1.f / 512.f) + RMS_EPS);
                  rsr[row] = ra / rb; rsbv[row] = rb; } }
            __syncthreads();
            EpiOut E{R, out, rsr, rsbv, (LAS const unsigned char*)(lds + LDS_GB_OFF)};
            pg8::gemm_phase<EpiOut, pg8::StaticOrder, true, true>(lds, g, S, E, wv);
        }
        GRID_SYNC();
        if (PH_MASK & 128) { unsigned char* ws = K_WS(); ln_rows<true>((const bf16_t*)(ws + WS_ZB), nullptr, (bf16_t*)(ws + WS_XB), (float*)(ws + WS_MU1), (float*)(ws + WS_RS1), K_IN(9) + l * DM, K_IN(10) + l * DM, NGW, wv); }
        GRID_SYNC();
        for (int rep_ = 0; rep_ < ((DUP_MASK & 256) ? 2 : 1); ++rep_) if (PH_MASK & 256) {
            unsigned char* ws = K_WS(); unsigned char* wl = W_BASE(l);
            pg8::Gemm g{(const bf16_t*)(ws + WS_XB), (const bf16_t*)(wl + WO_1), T_TOK, DFF, DM}; pg8::StaticOrder S; S.init(T_TOK, DFF, G, bx);
            EpiFfn1 E{(bf16_t*)(ws + WS_HF)};
            pg8::gemm_phase<EpiFfn1, pg8::StaticOrder, true, true>(lds, g, S, E, wv);
        }
        GRID_SYNC();
        if (PH_MASK & 512) {
            unsigned char* ws = K_WS(); unsigned char* wl = W_BASE(l);
            pg8::Gemm g{(const bf16_t*)(ws + WS_HF), (const bf16_t*)(wl + WO_2), T_TOK, DM, DFF}; pg8::StaticOrder S; S.init(T_TOK, DM, G, bx);
            bf16_t* out = (bf16_t*)(ws + WS_ZB);
            ResLn R; R.ln = 1; R.x32 = nullptr; R.zb = (const bf16_t*)out; R.mu = (const float*)(ws + WS_MU1); R.rs = (const float*)(ws + WS_RS1);
            { const float* gsrc = K_IN(9) + l * DM; const float* bsrc = K_IN(10) + l * DM; const int t_ = wv * 64 + lane_id();
              ((LAS float*)(lds + LDS_GB_OFF))[t_] = gsrc[t_]; ((LAS float*)(lds + LDS_GB_OFF))[t_ + 512] = gsrc[t_ + 512];
              ((LAS float*)(lds + LDS_GB_OFF + 4096))[t_] = bsrc[t_]; ((LAS float*)(lds + LDS_GB_OFF + 4096))[t_ + 512] = bsrc[t_ + 512]; }
            __syncthreads();
            EpiFfn2 E{R, out, (LAS const unsigned char*)(lds + LDS_GB_OFF)};
            pg8::gemm_phase<EpiFfn2, pg8::StaticOrder, true, true>(lds, g, S, E, wv);
        }
        GRID_SYNC();
        if (PH_MASK & 128) { unsigned char* ws = K_WS();
            if (l + 1 < DEPTH) ln_rows<true>((const bf16_t*)(ws + WS_ZB), nullptr, (bf16_t*)(ws + WS_XB), (float*)(ws + WS_MU2), (float*)(ws + WS_RS2), K_IN(13) + l * DM, K_IN(14) + l * DM, NGW, wv);
            else ln_rows<false>((const bf16_t*)(ws + WS_ZB), K_OUT(), nullptr, nullptr, nullptr, K_IN(13) + l * DM, K_IN(14) + l * DM, NGW, wv); }
        GRID_SYNC();
    }
}

extern "C" void kernel_launch(void* const* d_in, const int* in_sizes, int n_in, void* d_out, int out_size, void* d_ws, size_t ws_size, hipStream_t stream) {
    static int grid = 0;
    if (grid == 0) {
        if (n_in != 15 || out_size != T_TOK * DM || ws_size < WS_END) { fprintf(stderr, "kernel_launch: unexpected shapes (n_in %d out %d ws %zu)\n", n_in, out_size, ws_size); grid = -1; return; }
        int dev = 0, cus = 0, per_cu = 0;
        hipGetDevice(&dev);
        hipDeviceGetAttribute(&cus, hipDeviceAttributeMultiprocessorCount, dev);
        if (hipFuncSetAttribute((const void*)fwd_mega, hipFuncAttributeMaxDynamicSharedMemorySize, LDS_BYTES) != hipSuccess) { fprintf(stderr, "kernel_launch: hipFuncSetAttribute failed\n"); grid = -1; return; }
        if (hipOccupancyMaxActiveBlocksPerMultiprocessor(&per_cu, (const void*)fwd_mega, 512, LDS_BYTES) != hipSuccess || per_cu < 1) { fprintf(stderr, "kernel_launch: occupancy query gave %d\n", per_cu); per_cu = 1; }
        (void)hipGetLastError();
        grid = cus * per_cu;
        fprintf(stderr, "kernel_launch: grid %d (cus %d x %d)\n", grid, cus, per_cu);
    }
    if (grid < 0) return;
    if (hipMemsetAsync((char*)d_ws + WS_CTL, 0, CTL_ZERO_BYTES, stream) != hipSuccess) { fprintf(stderr, "kernel_launch: memset failed\n"); return; }
    Args a{};
    for (int i = 0; i < 15; ++i) a.in[i] = (const float*)d_in[i];
    a.out = (float*)d_out; a.ws = (unsigned char*)d_ws;
    void* kargs[] = {&a};
    hipError_t e = hipLaunchCooperativeKernel((const void*)fwd_mega, dim3(grid), dim3(512), kargs, LDS_BYTES, stream);
    if (e != hipSuccess) fprintf(stderr, "kernel_launch: cooperative launch failed: %s (grid %d)\n", hipGetErrorString(e), grid);
}
```

```cpp
#include <hip/hip_runtime.h>
#include <hip/hip_cooperative_groups.h>
#include <cstdio>
#include <cstdint>
namespace cg = cooperative_groups;

#ifndef DUP_MASK
#define DUP_MASK 0
#endif
#ifndef PH_MASK
#define PH_MASK 1023
#endif
#ifndef USE_XCD_BARRIER
#define USE_XCD_BARRIER 1
#endif

__device__ __forceinline__ int lane_id_v() { int l; asm volatile("v_mbcnt_lo_u32_b32 %0, -1, 0\n\tv_mbcnt_hi_u32_b32 %0, -1, %0" : "=v"(l)); return l; }
namespace pg8 {
#define PG8_LAS __attribute__((address_space(3)))
typedef unsigned short bf16_t;
typedef short bf16x8 __attribute__((ext_vector_type(8)));
typedef float f32x4 __attribute__((ext_vector_type(4)));
typedef unsigned u32x4 __attribute__((ext_vector_type(4)));
typedef unsigned u32x2 __attribute__((ext_vector_type(2)));
constexpr int BM = 256, BK = 64, HALF = 128, HTB = HALF * BK * 2, STAGE_BYTES = 8 * HTB, NXCD = 8, WGM = 8;

__host__ __device__ __forceinline__ int lds_byte(int r, int c) { const int st = (r >> 4) * 2 + (c >> 5), rr = r & 15, cc = c & 31, ob = rr * 64 + cc * 2; return st * 1024 + (ob ^ (((ob >> 9) & 1) << 5)); }
__host__ __device__ __forceinline__ void stage_rc(int b, int& R, int& C) { const int st = b / 1024, sb = b % 1024, swz = sb ^ (((sb >> 9) & 1) << 5); R = (st >> 1) * 16 + swz / 64; C = (st & 1) * 32 + (swz % 64) / 2; }
__host__ __device__ __forceinline__ int perm32(int rho) { const int n = rho >> 4, i = rho & 15; return 8 * (i >> 2) + 4 * n + (i & 3); }

struct Unit { int pm, pn; };
struct Gemm { const bf16_t* A; const bf16_t* Bt; int M, N, K; };

struct StaticOrder {
    int nM, nN, nwg, G, c;
    __host__ __device__ void init(int M, int N, int G_, int c_) { nM = M / BM; nN = N / BM; nwg = nM * nN; G = G_; c = c_; }
    __host__ __device__ bool next(int i, Unit& u) const {
        const long L = (long)i * G + c; if (L >= nwg) return false;
        int wgid = (int)L; { const int q = nwg / NXCD, r = nwg % NXCD, xcd = wgid % NXCD, off = wgid / NXCD; wgid = (xcd < r ? xcd * (q + 1) : r * (q + 1) + (xcd - r) * q) + off; }
        const int nig = WGM * nN, gid = wgid / nig, fm = gid * WGM, gsz = (nM - fm) < WGM ? (nM - fm) : WGM;
        u.pm = fm + ((wgid % nig) % gsz); u.pn = (wgid % nig) / gsz; return true;
    }
};

__device__ __forceinline__ unsigned cvt_pk_bf16(float lo, float hi) { unsigned r; asm volatile("v_cvt_pk_bf16_f32 %0, %1, %2" : "=v"(r) : "v"(lo), "v"(hi)); return r; }

template <class Epi, class Sched, bool ALIGN_EPI = false, bool SP2 = false>
__device__ __forceinline__ void gemm_phase(PG8_LAS unsigned char* lds, const Gemm g, const Sched& S, const Epi& E, int wv) {
    int tid_o = wv * 64 + lane_id_v(); asm volatile("" : "+v"(tid_o));
    const int tid = tid_o, wid = __builtin_amdgcn_readfirstlane(tid >> 6), lane = tid & 63, wr = wid >> 2, wc = wid & 3, fr = lane & 15, fq = lane >> 4;
    const int K = g.K, nt = K / BK;
    unsigned voffA[2], voffB[2];
#pragma unroll
    for (int i = 0; i < 2; ++i) { int R, C; stage_rc(tid * 16 + i * 8192, R, C); const int Rb = Epi::PERM ? ((R & ~31) + perm32(R & 31)) : R;
        voffA[i] = (unsigned)(R * K + C) * 2u; voffB[i] = (unsigned)(Rb * K + C) * 2u; }
    const size_t kstep = (size_t)(BK * 2);
    const size_t hstep = (size_t)HALF * K * 2;
    const size_t tstep = 2 * hstep;
    const unsigned ldsw = (unsigned)wid * 1024u;
    const int aoff = lds_byte(wr * 64 + fr, fq * 8), boff = lds_byte(wc * 32 + fr, fq * 8);
#define PG8_SA(b, h) (((b) * 2 + (h)) * HTB)
#define PG8_SB(b, h) ((4 + (b) * 2 + (h)) * HTB)
#define PG8_STAGE(bufoff, gbase, voff) do { _Pragma("unroll") for (int _i = 0; _i < 2; ++_i) \
        __builtin_amdgcn_global_load_lds((const unsigned*)((const char*)(gbase) + (voff)[_i]), (PG8_LAS unsigned*)(lds + (bufoff) + ldsw + _i * 8192), 16, 0, 0); } while (0)
#define PG8_LDA(dst, b, h) do { _Pragma("unroll") for (int m = 0; m < 4; ++m) _Pragma("unroll") for (int k = 0; k < 2; ++k) dst[m][k] = *(const PG8_LAS bf16x8*)(lds + PG8_SA(b, h) + aoff + m * 2048 + k * 1024); } while (0)
#define PG8_LDB(dst, b, h) do { _Pragma("unroll") for (int n = 0; n < 2; ++n) _Pragma("unroll") for (int k = 0; k < 2; ++k) dst[n][k] = *(const PG8_LAS bf16x8*)(lds + PG8_SB(b, h) + boff + n * 2048 + k * 1024); } while (0)
#define PG8_MMA(ai, bj, At, Bt) do { __builtin_amdgcn_s_setprio(1); _Pragma("unroll") for (int m = 0; m < 4; ++m) _Pragma("unroll") for (int n = 0; n < 2; ++n) _Pragma("unroll") for (int k = 0; k < 2; ++k) \
        acc[ai][bj][m][n] = __builtin_amdgcn_mfma_f32_16x16x32_bf16(Bt[n][k], At[m][k], acc[ai][bj][m][n], 0, 0, 0); __builtin_amdgcn_s_setprio(0); } while (0)
#define PG8_WAIT_V(n) asm volatile("s_waitcnt vmcnt(" #n ")" ::: "memory")
#define PG8_WAIT_L(n) asm volatile("s_waitcnt lgkmcnt(" #n ")" ::: "memory")
#define PG8_BAR __builtin_amdgcn_s_barrier()
#define PG8_SCHED __builtin_amdgcn_sched_barrier(0)
    Unit cur, nxt; int ui = 0;
    if (!S.next(0, cur)) return;
    f32x4 acc[2][2][4][2];
#pragma unroll
    for (int a = 0; a < 2; ++a)
#pragma unroll
        for (int b = 0; b < 2; ++b)
#pragma unroll
            for (int m = 0; m < 4; ++m)
#pragma unroll
                for (int n = 0; n < 2; ++n) acc[a][b][m][n] = (f32x4){0.f, 0.f, 0.f, 0.f};
    bf16x8 At[4][2], B0[2][2], B1[2][2];
    const char* cA = (const char*)g.A + (size_t)cur.pm * tstep; const char* cB = (const char*)g.Bt + (size_t)cur.pn * tstep;
    if constexpr (SP2) {
        PG8_STAGE(PG8_SB(0, 0), cB, voffB); PG8_STAGE(PG8_SB(0, 1), cB + hstep, voffB); PG8_STAGE(PG8_SA(0, 0), cA, voffA); PG8_STAGE(PG8_SA(0, 1), cA + hstep, voffA);
        if (wr == 1) PG8_BAR;
        PG8_WAIT_V(2); PG8_BAR;
        PG8_STAGE(PG8_SB(1, 0), cB + kstep, voffB); PG8_STAGE(PG8_SA(1, 0), cA + kstep, voffA); PG8_STAGE(PG8_SB(1, 1), cB + hstep + kstep, voffB);
        PG8_WAIT_V(6); PG8_BAR;
    } else {
        PG8_STAGE(PG8_SB(0, 0), cB, voffB); PG8_STAGE(PG8_SA(0, 0), cA, voffA); PG8_STAGE(PG8_SB(0, 1), cB + hstep, voffB); PG8_STAGE(PG8_SA(0, 1), cA + hstep, voffA);
        if (wr == 1) PG8_BAR;
        PG8_WAIT_V(4); PG8_BAR;
        PG8_STAGE(PG8_SB(1, 0), cB + kstep, voffB); PG8_STAGE(PG8_SA(1, 0), cA + kstep, voffA); PG8_STAGE(PG8_SB(1, 1), cB + hstep + kstep, voffB);
        PG8_WAIT_V(6); PG8_BAR;
    }
    for (;;) {
        const bool has_next = S.next(ui + 1, nxt);
        const char* nA = has_next ? (const char*)g.A + (size_t)nxt.pm * tstep : cA; const char* nB = has_next ? (const char*)g.Bt + (size_t)nxt.pn * tstep : cB;
        for (int t = 0; t < nt; t += 2) {
            const bool last = (t == nt - 2);
            if constexpr (Epi::MID) { if (t == (nt >> 1)) { int t2 = lane_id_v(); asm volatile("" : "+v"(t2)); E.mid(acc, cur, wr, wc, t2 & 15, (t2 >> 4) & 3); } }
            const char* a1 = cA + (size_t)(t + 1) * kstep;
            const char* a2 = last ? nA : cA + (size_t)(t + 2) * kstep; const char* b2 = last ? nB : cB + (size_t)(t + 2) * kstep;
            const char* a3 = a2 + kstep; const char* b3 = b2 + kstep;
            if constexpr (SP2) {
            PG8_LDB(B0, 0, 0); PG8_LDB(B1, 0, 1); PG8_SCHED; PG8_LDA(At, 0, 0); PG8_STAGE(PG8_SA(1, 1), a1 + hstep, voffA);
            PG8_WAIT_V(8); PG8_WAIT_L(0); PG8_BAR; PG8_MMA(0, 0, At, B0); PG8_MMA(0, 1, At, B1); PG8_BAR; PG8_SCHED;
            PG8_LDA(At, 0, 1); PG8_STAGE(PG8_SB(0, 0), b2, voffB); PG8_STAGE(PG8_SB(0, 1), b2 + hstep, voffB); PG8_STAGE(PG8_SA(0, 0), a2, voffA);
            PG8_WAIT_V(8); PG8_WAIT_L(0); PG8_BAR; PG8_MMA(1, 0, At, B0); PG8_MMA(1, 1, At, B1); PG8_BAR; PG8_SCHED;
            PG8_LDB(B0, 1, 0); PG8_LDB(B1, 1, 1); PG8_SCHED; PG8_LDA(At, 1, 0); PG8_STAGE(PG8_SA(0, 1), a2 + hstep, voffA);
            PG8_WAIT_V(8); PG8_WAIT_L(0); PG8_BAR; PG8_MMA(0, 0, At, B0); PG8_MMA(0, 1, At, B1); PG8_BAR; PG8_SCHED;
            PG8_LDA(At, 1, 1); PG8_STAGE(PG8_SB(1, 0), b3, voffB); PG8_STAGE(PG8_SB(1, 1), b3 + hstep, voffB); PG8_STAGE(PG8_SA(1, 0), a3, voffA);
            PG8_WAIT_V(8); PG8_WAIT_L(0); PG8_BAR; PG8_MMA(1, 0, At, B0); PG8_MMA(1, 1, At, B1); PG8_BAR; PG8_SCHED;
            } else {
            PG8_LDB(B0, 0, 0); PG8_SCHED; PG8_LDA(At, 0, 0); PG8_STAGE(PG8_SA(1, 1), a1 + hstep, voffA);
            PG8_WAIT_L(8); PG8_BAR; PG8_WAIT_L(0); PG8_MMA(0, 0, At, B0); PG8_BAR; PG8_SCHED;
            PG8_LDB(B1, 0, 1); PG8_STAGE(PG8_SB(0, 0), b2, voffB);
            PG8_BAR; PG8_WAIT_L(0); PG8_MMA(0, 1, At, B1); PG8_BAR;
            PG8_LDA(At, 0, 1); PG8_STAGE(PG8_SA(0, 0), a2, voffA);
            PG8_BAR; PG8_WAIT_L(0); PG8_MMA(1, 0, At, B0); PG8_BAR; PG8_SCHED;
            PG8_STAGE(PG8_SB(0, 1), b2 + hstep, voffB);
            PG8_WAIT_V(6); PG8_BAR; PG8_MMA(1, 1, At, B1); PG8_BAR;
            PG8_LDB(B0, 1, 0); PG8_SCHED; PG8_LDA(At, 1, 0); PG8_STAGE(PG8_SA(0, 1), a2 + hstep, voffA);
            PG8_WAIT_L(8); PG8_BAR; PG8_WAIT_L(0); PG8_MMA(0, 0, At, B0); PG8_BAR; PG8_SCHED;
            PG8_LDB(B1, 1, 1); PG8_STAGE(PG8_SB(1, 0), b3, voffB);
            PG8_BAR; PG8_WAIT_L(0); PG8_MMA(0, 1, At, B1); PG8_BAR;
            PG8_LDA(At, 1, 1); PG8_STAGE(PG8_SA(1, 0), a3, voffA);
            PG8_BAR; PG8_WAIT_L(0); PG8_MMA(1, 0, At, B0); PG8_BAR; PG8_SCHED;
            PG8_STAGE(PG8_SB(1, 1), b3 + hstep, voffB);
            PG8_WAIT_V(6); PG8_BAR; PG8_MMA(1, 1, At, B1); PG8_BAR;
            }
        }
        if constexpr (ALIGN_EPI) { if (wr == 0) PG8_BAR; }
        { int t2 = lane_id_v(); asm volatile("" : "+v"(t2)); E(acc, cur, wr, wc, t2 & 15, (t2 >> 4) & 3); }
        if (!has_next) break;
#pragma unroll
        for (int a = 0; a < 2; ++a)
#pragma unroll
            for (int b = 0; b < 2; ++b)
#pragma unroll
                for (int m = 0; m < 4; ++m)
#pragma unroll
                    for (int n = 0; n < 2; ++n) acc[a][b][m][n] = (f32x4){0.f, 0.f, 0.f, 0.f};
        cur = nxt; cA = nA; cB = nB; ++ui;
        if constexpr (ALIGN_EPI) { if (wr == 1) PG8_BAR; }
    }
    PG8_WAIT_V(0);
    if constexpr (!ALIGN_EPI) { if (wr == 0) PG8_BAR; }
    PG8_BAR;
#undef PG8_SA
#undef PG8_SB
#undef PG8_STAGE
#undef PG8_LDA
#undef PG8_LDB
#undef PG8_MMA
#undef PG8_WAIT_V
#undef PG8_WAIT_L
#undef PG8_BAR
#undef PG8_SCHED
}
}

using pg8::bf16_t; using pg8::bf16x8; using pg8::f32x4; using pg8::u32x4; using pg8::u32x2; using pg8::Unit; using pg8::cvt_pk_bf16;
typedef float f32x16 __attribute__((ext_vector_type(16)));
#define LAS __attribute__((address_space(3)))

constexpr int T_TOK = 32768, SEQ = 4096, DM = 1024, NBATCH = 8, DEPTH = 4, DFF = 4096;
constexpr int IN_COLS = 1984, IN_PAD = 2048;
constexpr float ALPHA = 1.6817928305074290f;
constexpr float LN_EPS = 1e-5f, RMS_EPS = 1e-6f;
constexpr float LOG2E = 1.4426950408889634f;
constexpr float QSCALE_A = 0.125f * LOG2E;
constexpr float QSCALE_M = 0.07216878364870322f * LOG2E;

constexpr size_t MiB = 1u << 20;
constexpr size_t WS_CTL = 0, CTL_ZERO_BYTES = 64 * 1024;
constexpr size_t WS_ROPE = 1 * MiB;
constexpr size_t WS_PCQ = 2 * MiB;
constexpr size_t WS_PCKV = 2 * MiB + 512 * 1024;
constexpr size_t WS_SSA = 3 * MiB;
constexpr size_t WS_SSB = 4 * MiB;
constexpr size_t WS_LSE = 5 * MiB;
constexpr size_t WS_RSQ = 7 * MiB, WS_RSKV = 7 * MiB + 128 * 1024, WS_RSR = 7 * MiB + 256 * 1024, WS_RSB = 7 * MiB + 384 * 1024;
constexpr size_t WS_MU1 = 7 * MiB + 512 * 1024, WS_RS1 = 7 * MiB + 640 * 1024, WS_MU2 = 7 * MiB + 768 * 1024, WS_RS2 = 7 * MiB + 896 * 1024;
constexpr size_t WS_W = 8 * MiB;
constexpr size_t W_LAYER_BYTES = 23 * MiB;
constexpr size_t WS_ZB = 32 * MiB;
constexpr size_t WO_IN = 0, WO_UQ = 4 * MiB, WO_UKV = 4 * MiB + 512 * 1024, WO_O = 5 * MiB, WO_1 = 7 * MiB, WO_2 = 15 * MiB;
constexpr size_t WS_XB = 100 * MiB;
constexpr size_t WS_QA = 164 * MiB, WS_KA = 196 * MiB, WS_VA = 228 * MiB, WS_CQ = 260 * MiB, WS_CKV = 276 * MiB;
constexpr size_t WS_QM = 284 * MiB, WS_KM = 332 * MiB, WS_VM = 380 * MiB, WS_AO = 412 * MiB, WS_END = 476 * MiB;
constexpr size_t WS_HF = 164 * MiB;

constexpr int LDS_BYTES = 147456;

typedef float f32x2_t __attribute__((ext_vector_type(2))); typedef __bf16 bf16x2_t __attribute__((ext_vector_type(2)));
__device__ __forceinline__ unsigned cvtpk(float lo, float hi) { f32x2_t v = {lo, hi}; bf16x2_t b = __builtin_convertvector(v, bf16x2_t); return __builtin_bit_cast(unsigned, b); }
__device__ __forceinline__ float bf_lo(unsigned u) { return __uint_as_float(u << 16); }
__device__ __forceinline__ float bf_hi(unsigned u) { return __uint_as_float(u & 0xffff0000u); }
__device__ __forceinline__ void st_bf16x4(bf16_t* p, f32x4 v) { u32x2 w; w.x = cvtpk(v[0], v[1]); w.y = cvtpk(v[2], v[3]); *(u32x2*)p = w; }
template <int XM> __device__ __forceinline__ float swz_xor(float v) { return __int_as_float(__builtin_amdgcn_ds_swizzle(__float_as_int(v), (XM << 10) | 0x1f)); }
__device__ __forceinline__ float xadd32(float v) { auto rr = __builtin_amdgcn_permlane32_swap(__float_as_uint(v), __float_as_uint(v), false, false); return __uint_as_float(rr[0]) + __uint_as_float(rr[1]); }
__device__ __forceinline__ float xmax32(float v) { auto rr = __builtin_amdgcn_permlane32_swap(__float_as_uint(v), __float_as_uint(v), false, false); return fmaxf(__uint_as_float(rr[0]), __uint_as_float(rr[1])); }
__device__ __forceinline__ float wave_sum(float v) {
    v += swz_xor<1>(v); v += swz_xor<2>(v); v += swz_xor<4>(v); v += swz_xor<8>(v); v += swz_xor<16>(v);
    return xadd32(v);
}
__device__ __forceinline__ int lane_id() { return lane_id_v(); }
__device__ __forceinline__ int crow(int r, int hi) { return (r & 3) + 8 * (r >> 2) + 4 * hi; }

__device__ __forceinline__ void st_bf16x8(bf16_t* p, f32x4 a, f32x4 b) { u32x4 w; w.x = cvtpk(a[0], a[1]); w.y = cvtpk(a[2], a[3]); w.z = cvtpk(b[0], b[1]); w.w = cvtpk(b[2], b[3]); *(u32x4*)p = w; }
__device__ __forceinline__ float sumsq8(f32x4 a, f32x4 b) { return ((a[0] * a[0] + a[1] * a[1]) + (a[2] * a[2] + a[3] * a[3])) + ((b[0] * b[0] + b[1] * b[1]) + (b[2] * b[2] + b[3] * b[3])); }
struct EpiIn {
    static constexpr bool PERM = true, MID = false;
    bf16_t *QA, *KA, *VA, *CQ, *CKV, *KM; float *pcq, *pckv; const float* cs;
    __device__ __forceinline__ void operator()(const f32x4 (&acc)[2][2][4][2], const Unit& u, int wr, int wc, int fr, int fq) const {
        const int pn = u.pn; const int row0 = u.pm * 256 + wr * 64 + fr;
        if (pn < 4) {
            bf16_t* base = (pn < 2) ? QA : KA; const float sc = (pn < 2) ? QSCALE_A : 1.f;
#pragma unroll
            for (int ai = 0; ai < 2; ++ai) {
                f32x4 cv[4][4];
#pragma unroll
                for (int m = 0; m < 4; ++m) { const int pos = (row0 + ai * 128 + m * 16) & (SEQ - 1); const float* cp = cs + pos * 32 + 8 * fq;
                    cv[m][0] = *(const f32x4*)cp; cv[m][1] = *(const f32x4*)(cp + 4); cv[m][2] = *(const f32x4*)(cp + SEQ * 32); cv[m][3] = *(const f32x4*)(cp + SEQ * 32 + 4); }
#pragma unroll
                for (int m = 0; m < 4; ++m) {
                    const int row = row0 + ai * 128 + m * 16;
                    const f32x4 c0 = cv[m][0] * sc, c1 = cv[m][1] * sc, s0 = cv[m][2] * sc, s1 = cv[m][3] * sc;
                    const f32x4 xa0 = acc[ai][0][m][0], xa1 = acc[ai][0][m][1], xb0 = acc[ai][1][m][0], xb1 = acc[ai][1][m][1];
                    bf16_t* p = base + (unsigned)(row * 512 + 256 * (pn & 1) + 64 * wc + 8 * fq);
                    st_bf16x8(p, xa0 * c0 - xb0 * s0, xa1 * c1 - xb1 * s1); st_bf16x8(p + 32, xb0 * c0 + xa0 * s0, xb1 * c1 + xa1 * s1);
                }
                asm volatile("" ::: "memory");
            }
        } else if (pn < 7) {
            bf16_t* dst = (pn < 6) ? VA : CQ; const int ld = (pn < 6) ? 512 : 256; const int cb = (pn == 5) ? 256 : 0;
#pragma unroll
            for (int ai = 0; ai < 2; ++ai)
#pragma unroll
                for (int m = 0; m < 4; ++m) {
                    const int row = row0 + ai * 128 + m * 16; float ss = 0.f;
#pragma unroll
                    for (int bj = 0; bj < 2; ++bj) { ss += sumsq8(acc[ai][bj][m][0], acc[ai][bj][m][1]);
                        st_bf16x8(dst + (unsigned)(row * ld + cb + 128 * bj + 32 * wc + 8 * fq), acc[ai][bj][m][0], acc[ai][bj][m][1]); }
                    if (pn == 6) { ss += swz_xor<16>(ss); ss = xadd32(ss); if (fq == 0) pcq[row * 4 + wc] = ss; }
                }
        } else {
#pragma unroll
            for (int ai = 0; ai < 2; ++ai)
#pragma unroll
                for (int m = 0; m < 4; ++m) {
                    const int row = row0 + ai * 128 + m * 16; float ss = 0.f;
                    if (wc < 3) { ss += sumsq8(acc[ai][0][m][0], acc[ai][0][m][1]); st_bf16x8(CKV + (unsigned)(row * 128 + 32 * wc + 8 * fq), acc[ai][0][m][0], acc[ai][0][m][1]); }
                    if (wc == 0) { ss += sumsq8(acc[ai][1][m][0], acc[ai][1][m][1]); st_bf16x8(CKV + (unsigned)(row * 128 + 96 + 8 * fq), acc[ai][1][m][0], acc[ai][1][m][1]); }
                    ss += swz_xor<16>(ss); ss = xadd32(ss); if (fq == 0) pckv[row * 4 + wc] = ss;
                    if (wc == 3) {
                        const int pos = row & (SEQ - 1); const float* cp = cs + pos * 32 + 8 * fq;
                        const f32x4 c0 = *(const f32x4*)cp, c1 = *(const f32x4*)(cp + 4), s0 = *(const f32x4*)(cp + SEQ * 32), s1 = *(const f32x4*)(cp + SEQ * 32 + 4);
                        const f32x4 xa0 = acc[ai][0][m][0], xa1 = acc[ai][0][m][1], xb0 = acc[ai][1][m][0], xb1 = acc[ai][1][m][1];
                        const f32x4 o10 = xa0 * c0 - xb0 * s0, o11 = xa1 * c1 - xb1 * s1, o20 = xb0 * c0 + xa0 * s0, o21 = xb1 * c1 + xa1 * s1;
#pragma unroll
                        for (int h = 0; h < 4; ++h) { bf16_t* p = KM + (unsigned)(row * 768 + h * 192 + 128 + 8 * fq); st_bf16x8(p, o10, o11); st_bf16x8(p + 32, o20, o21); }
                    }
                }
        }
    }
};

struct EpiUpQ {
    static constexpr bool PERM = true, MID = false;
    bf16_t* QM; const float* rsq; const float* cs;
    __device__ __forceinline__ void operator()(const f32x4 (&acc)[2][2][4][2], const Unit& u, int wr, int wc, int fr, int fq) const {
        const int pn = u.pn; const int row0 = u.pm * 256 + wr * 64 + fr;
#pragma unroll
        for (int ai = 0; ai < 2; ++ai)
#pragma unroll
            for (int m = 0; m < 4; ++m) {
                const int row = row0 + ai * 128 + m * 16;
                const float rs = rsq[row];
                if (pn < 2) {
#pragma unroll
                    for (int bj = 0; bj < 2; ++bj)
                        st_bf16x8(QM + (unsigned)(row * 768 + (2 * pn + bj) * 192 + 32 * wc + 8 * fq), acc[ai][bj][m][0] * rs, acc[ai][bj][m][1] * rs);
                } else {
                    const int pos = row & (SEQ - 1); const float* cp = cs + pos * 32 + 8 * fq;
                    const f32x4 c0 = *(const f32x4*)cp * rs, c1 = *(const f32x4*)(cp + 4) * rs, s0 = *(const f32x4*)(cp + SEQ * 32) * rs, s1 = *(const f32x4*)(cp + SEQ * 32 + 4) * rs;
                    const f32x4 xa0 = acc[ai][0][m][0], xa1 = acc[ai][0][m][1], xb0 = acc[ai][1][m][0], xb1 = acc[ai][1][m][1];
                    bf16_t* p = QM + (unsigned)(row * 768 + wc * 192 + 128 + 8 * fq);
                    st_bf16x8(p, xa0 * c0 - xb0 * s0, xa1 * c1 - xb1 * s1); st_bf16x8(p + 32, xb0 * c0 + xa0 * s0, xb1 * c1 + xa1 * s1);
                }
                if (m & 1) asm volatile("" ::: "memory");
            }
    }
};

struct EpiUpKV {
    static constexpr bool PERM = true, MID = false;
    bf16_t *KM, *VM; const float* rskv;
    __device__ __forceinline__ void operator()(const f32x4 (&acc)[2][2][4][2], const Unit& u, int wr, int wc, int fr, int fq) const {
        const int pn = u.pn; const int row0 = u.pm * 256 + wr * 64 + fr;
#pragma unroll
        for (int ai = 0; ai < 2; ++ai)
#pragma unroll
            for (int m = 0; m < 4; ++m) {
                const int row = row0 + ai * 128 + m * 16;
                const float rs = rskv[row];
                st_bf16x8(KM + (unsigned)(row * 768 + pn * 192 + 32 * wc + 8 * fq), acc[ai][0][m][0] * rs, acc[ai][0][m][1] * rs);
                st_bf16x8(VM + (unsigned)(row * 512 + pn * 128 + 32 * wc + 8 * fq), acc[ai][1][m][0] * rs, acc[ai][1][m][1] * rs);
                if (m & 1) asm volatile("" ::: "memory");
            }
    }
};

constexpr int LDS_GB_OFF = 131072 + 1024;
struct ResLn { const float* x32; const bf16_t* zb; const float* mu; const float* rs; int ln; };
__device__ __forceinline__ void ld8_bf16(const bf16_t* p, f32x4& a, f32x4& b) { const u32x4 w = *(const u32x4*)p; a = (f32x4){bf_lo(w.x), bf_hi(w.x), bf_lo(w.y), bf_hi(w.y)}; b = (f32x4){bf_lo(w.z), bf_hi(w.z), bf_lo(w.w), bf_hi(w.w)}; }
__device__ __forceinline__ void resid_epilogue(const f32x4 (&acc)[2][2][4][2], const ResLn& R, bf16_t* zout, const float* rsb, LAS const unsigned char* lds_gb, const Unit& u, int wr, int wc, int fr, int fq) {
    const int row0 = u.pm * 256 + wr * 64 + fr; const int col0 = u.pn * 256 + 32 * wc + 8 * fq;
    if (R.ln) {
#pragma unroll
        for (int ai = 0; ai < 2; ++ai) {
            u32x4 zr[4][2]; float mu[4], rs[4], rb[4];
#pragma unroll
            for (int m = 0; m < 4; ++m) { const int row = row0 + ai * 128 + m * 16; rb[m] = rsb ? rsb[row] : 1.f; mu[m] = R.mu[row]; rs[m] = R.rs[row];
                zr[m][0] = *(const u32x4*)(R.zb + (unsigned)(row * DM + col0)); zr[m][1] = *(const u32x4*)(R.zb + (unsigned)(row * DM + col0 + 128)); }
#pragma unroll
            for (int bj = 0; bj < 2; ++bj) {
                const int col = col0 + 128 * bj;
                const f32x4 g0 = *(const LAS f32x4*)(lds_gb + col * 4), g1 = *(const LAS f32x4*)(lds_gb + col * 4 + 16), b0 = *(const LAS f32x4*)(lds_gb + 4096 + col * 4), b1 = *(const LAS f32x4*)(lds_gb + 4096 + col * 4 + 16);
#pragma unroll
                for (int m = 0; m < 4; ++m) { const int row = row0 + ai * 128 + m * 16; const u32x4 w = zr[m][bj];
                    const f32x4 z0 = {bf_lo(w.x), bf_hi(w.x), bf_lo(w.y), bf_hi(w.y)}, z1 = {bf_lo(w.z), bf_hi(w.z), bf_lo(w.w), bf_hi(w.w)};
                    const f32x4 x0 = (z0 - mu[m]) * rs[m] * g0 + b0, x1 = (z1 - mu[m]) * rs[m] * g1 + b1;
                    st_bf16x8(zout + (unsigned)(row * DM + col), x0 * ALPHA + acc[ai][bj][m][0] * rb[m], x1 * ALPHA + acc[ai][bj][m][1] * rb[m]); }
            }
            asm volatile("" ::: "memory");
        }
    } else {
#pragma unroll
        for (int ai = 0; ai < 2; ++ai) {
            f32x4 xr[4][2][2]; float rb[4];
#pragma unroll
            for (int m = 0; m < 4; ++m) { const int row = row0 + ai * 128 + m * 16; rb[m] = rsb ? rsb[row] : 1.f;
#pragma unroll
                for (int bj = 0; bj < 2; ++bj) { const float* p = R.x32 + (unsigned)(row * DM + col0 + 128 * bj); xr[m][bj][0] = *(const f32x4*)p; xr[m][bj][1] = *(const f32x4*)(p + 4); } }
#pragma unroll
            for (int m = 0; m < 4; ++m) { const int row = row0 + ai * 128 + m * 16;
#pragma unroll
                for (int bj = 0; bj < 2; ++bj)
                    st_bf16x8(zout + (unsigned)(row * DM + col0 + 128 * bj), xr[m][bj][0] * ALPHA + acc[ai][bj][m][0] * rb[m], xr[m][bj][1] * ALPHA + acc[ai][bj][m][1] * rb[m]); }
            asm volatile("" ::: "memory");
        }
    }
}
struct EpiOut {
    static constexpr bool PERM = true, MID = true;
    ResLn R; bf16_t* out; const float *rsr, *rsb; LAS const unsigned char* lds_gb;
    __device__ __forceinline__ void mid(f32x4 (&acc)[2][2][4][2], const Unit& u, int wr, int wc, int fr, int fq) const {
        const int row0 = u.pm * 256 + wr * 64 + fr;
#pragma unroll
        for (int ai = 0; ai < 2; ++ai)
#pragma unroll
            for (int m = 0; m < 4; ++m) { const float ratio = rsr[row0 + ai * 128 + m * 16];
#pragma unroll
                for (int bj = 0; bj < 2; ++bj)
#pragma unroll
                    for (int n = 0; n < 2; ++n) acc[ai][bj][m][n] *= ratio; }
    }
    __device__ __forceinline__ void operator()(const f32x4 (&acc)[2][2][4][2], const Unit& u, int wr, int wc, int fr, int fq) const {
        resid_epilogue(acc, R, out, rsb, lds_gb, u, wr, wc, fr, fq);
    }
};

struct EpiFfn1 {
    static constexpr bool PERM = true, MID = false;
    bf16_t* O;
    __device__ __forceinline__ void operator()(const f32x4 (&acc)[2][2][4][2], const Unit& u, int wr, int wc, int fr, int fq) const {
        const int row0 = u.pm * 256 + wr * 64 + fr; const int col0 = u.pn * 256 + wc * 32 + 8 * fq;
#pragma unroll
        for (int ai = 0; ai < 2; ++ai)
#pragma unroll
            for (int m = 0; m < 4; ++m) { bf16_t* rowp = O + (unsigned)((row0 + ai * 128 + m * 16) * DFF + col0);
#pragma unroll
                for (int bj = 0; bj < 2; ++bj) { f32x4 v0 = acc[ai][bj][m][0], v1 = acc[ai][bj][m][1];
#pragma unroll
                    for (int e = 0; e < 4; ++e) { const float a = fmaxf(v0[e], 0.f), b = fmaxf(v1[e], 0.f); v0[e] = a * a; v1[e] = b * b; }
                    u32x4 w; w.x = cvtpk(v0[0], v0[1]); w.y = cvtpk(v0[2], v0[3]); w.z = cvtpk(v1[0], v1[1]); w.w = cvtpk(v1[2], v1[3]);
                    *(u32x4*)(rowp + bj * 128) = w; } }
    }
};

struct EpiFfn2 {
    static constexpr bool PERM = true, MID = false;
    ResLn R; bf16_t* X; LAS const unsigned char* lds_gb;
    __device__ __forceinline__ void operator()(const f32x4 (&acc)[2][2][4][2], const Unit& u, int wr, int wc, int fr, int fq) const {
        resid_epilogue(acc, R, X, nullptr, lds_gb, u, wr, wc, fr, fq);
    }
};

__device__ __forceinline__ unsigned f2bf(float f) { unsigned u = __builtin_bit_cast(unsigned, f); return (u + 0x7fffu + ((u >> 16) & 1u)) >> 16; }
__device__ __forceinline__ unsigned pk2(float lo, float hi) { return f2bf(lo) | (f2bf(hi) << 16); }

__device__ __forceinline__ int map_in(int np) {
    const int pn = np >> 8, cc = np & 255, bj = cc >> 7, wc = (cc >> 5) & 3, r = cc & 31;
    if (pn < 4) return 256 * pn + 64 * wc + 32 * bj + r;
    if (pn < 7) return np;
    if (bj == 0) return (wc < 3) ? 1792 + 32 * wc + r : 1920 + r;
    return (wc == 0) ? 1792 + 96 + r : (wc == 3) ? 1920 + 32 + r : -1;
}
__device__ __forceinline__ int map_uq(int np) {
    const int pn = np >> 8, cc = np & 255, bj = cc >> 7, wc = (cc >> 5) & 3, r = cc & 31;
    if (pn < 2) return (2 * pn + bj) * 192 + (cc & 127);
    return wc * 192 + 128 + 32 * bj + r;
}
template <int MAP>
__device__ __forceinline__ void conv_item(const float* __restrict__ W, int K, int N, bf16_t* __restrict__ WT, const float* __restrict__ g0, const float* __restrict__ g1, int ksplit, int nb, int kb, int lane) {
    const int np = 64 * nb + lane, k0 = 64 * kb;
    const int src = (MAP == 1) ? map_in(np) : (MAP == 2) ? map_uq(np) : np;
    const float* wp = W + (size_t)k0 * N + (src >= 0 ? src : 0);
    bf16_t* op = WT + (size_t)np * K + k0;
#pragma unroll
    for (int h = 0; h < 2; ++h) {
        float v[32];
#pragma unroll
        for (int j = 0; j < 32; ++j) v[j] = wp[(size_t)(32 * h + j) * N];
        if (g0) {
#pragma unroll
            for (int j = 0; j < 32; ++j) { const int kx = k0 + 32 * h + j; v[j] *= (kx < ksplit) ? g0[kx] : g1[kx - ksplit]; }
        }
        if (src < 0) {
#pragma unroll
            for (int j = 0; j < 32; ++j) v[j] = 0.f;
        }
#pragma unroll
        for (int c = 0; c < 4; ++c) { u32x4 o; o.x = cvtpk(v[8 * c], v[8 * c + 1]); o.y = cvtpk(v[8 * c + 2], v[8 * c + 3]); o.z = cvtpk(v[8 * c + 4], v[8 * c + 5]); o.w = cvtpk(v[8 * c + 6], v[8 * c + 7]);
            *(u32x4*)(op + 32 * h + 8 * c) = o; }
    }
}

template <bool LITE>
__device__ __forceinline__ void ln_rows(const bf16_t* ZB, float* OUT32, bf16_t* XB, float* MU, float* RS, const float* g, const float* bt, int NGW, int wv) {
    int tid_o = wv * 64 + lane_id(); asm volatile("" : "+v"(tid_o));
    const int lane = tid_o & 63; const int gw = blockIdx.x * 8 + __builtin_amdgcn_readfirstlane(tid_o >> 6);
    const f32x4 g0 = ((const f32x4*)g)[lane], g1 = ((const f32x4*)g)[lane + 64], g2 = ((const f32x4*)g)[lane + 128], g3 = ((const f32x4*)g)[lane + 192];
    const f32x4 b0 = ((const f32x4*)bt)[lane], b1 = ((const f32x4*)bt)[lane + 64], b2 = ((const f32x4*)bt)[lane + 128], b3 = ((const f32x4*)bt)[lane + 192];
    for (int rowb = gw; rowb < T_TOK; rowb += 4 * NGW) {
        u32x2 zr[4][4];
#pragma unroll
        for (int q = 0; q < 4; ++q) { const int row = rowb + q * NGW; if (row < T_TOK) { const u32x2* xr = (const u32x2*)(ZB + (size_t)row * DM) + lane;
#pragma unroll
            for (int j = 0; j < 4; ++j) zr[q][j] = xr[64 * j]; } }
#pragma unroll
        for (int q = 0; q < 4; ++q) { const int row = rowb + q * NGW; if (row < T_TOK) {
            f32x4 v[4]; float s = 0.f;
#pragma unroll
            for (int j = 0; j < 4; ++j) { v[j] = (f32x4){bf_lo(zr[q][j].x), bf_hi(zr[q][j].x), bf_lo(zr[q][j].y), bf_hi(zr[q][j].y)}; s += (v[j][0] + v[j][1]) + (v[j][2] + v[j][3]); }
            const float mean = wave_sum(s) * (1.f / DM); float s2 = 0.f;
#pragma unroll
            for (int j = 0; j < 4; ++j) { v[j] = v[j] - mean; s2 += (v[j][0] * v[j][0] + v[j][1] * v[j][1]) + (v[j][2] * v[j][2] + v[j][3] * v[j][3]); }
            const float rstd = 1.f / sqrtf(wave_sum(s2) * (1.f / DM) + LN_EPS);
            v[0] = v[0] * rstd * g0 + b0; v[1] = v[1] * rstd * g1 + b1; v[2] = v[2] * rstd * g2 + b2; v[3] = v[3] * rstd * g3 + b3;
            if constexpr (LITE) {
                u32x2* o8 = (u32x2*)(XB + (size_t)row * DM) + lane;
#pragma unroll
                for (int j = 0; j < 4; ++j) { u32x2 w; w.x = cvtpk(v[j][0], v[j][1]); w.y = cvtpk(v[j][2], v[j][3]); o8[64 * j] = w; }
                if (lane == 0) { MU[row] = mean; RS[row] = rstd; }
            } else {
                f32x4* xr = (f32x4*)(OUT32 + (size_t)row * DM) + lane;
#pragma unroll
                for (int j = 0; j < 4; ++j) xr[64 * j] = v[j];
            }
        } }
    }
}

#define MFMA32(a, b, c) __builtin_amdgcn_mfma_f32_32x32x16_bf16((a), (b), (c), 0, 0, 0)
constexpr int MLA_KP = 400, MLA_VP = 136, MLA_KBUF = 64 * MLA_KP, MLA_VBUF = 128 * MLA_VP;
__device__ __forceinline__ void mla_unit(LAS char* shm, const bf16_t* __restrict__ QM, const bf16_t* __restrict__ KM, const bf16_t* __restrict__ VM, bf16_t* AO, float* ssB, int b, int h, int qb, int wv) {
    int tid_o = wv * 64 + lane_id(); asm volatile("" : "+v"(tid_o));
    const int tid = tid_o, lane = tid & 63, wid = __builtin_amdgcn_readfirstlane(tid >> 6), r32 = lane & 31, hi = lane >> 5;
    const size_t rowbase = (size_t)b * SEQ; const int q0 = qb * 256; const int NT = (q0 + 256) / 64;
    const int qw = q0 + wid * 32;
    bf16x8 qf[12];
    { const bf16_t* qp = QM + (rowbase + qw + r32) * 768 + h * 192 + hi * 8;
#pragma unroll
      for (int ks = 0; ks < 12; ++ks) qf[ks] = *(const bf16x8*)(qp + ks * 16); }
    int kkey[3], kch[3];
#pragma unroll
    for (int i = 0; i < 3; ++i) { const int id = tid + 512 * i; kkey[i] = id / 24; kch[i] = id % 24; }
    const int vc = 4 * (wid & 3) + (lane & 3), vkp = 16 * (wid >> 2) + (lane >> 2);
    const bf16_t* kg = KM + rowbase * 768 + h * 192; const bf16_t* vg = VM + rowbase * 512 + h * 128 + vc * 8;
    u32x4 kreg[3], vreg[2];
#define MLA_ISSUE(t) do { _Pragma("unroll") for (int i = 0; i < 3; ++i) kreg[i] = *(const u32x4*)(kg + (size_t)((t) * 64 + kkey[i]) * 768 + kch[i] * 8); \
        vreg[0] = *(const u32x4*)(vg + (size_t)((t) * 64 + 2 * vkp) * 512); vreg[1] = *(const u32x4*)(vg + (size_t)((t) * 64 + 2 * vkp + 1) * 512); } while (0)
#define MLA_WRITE(buf) do { LAS char* kb_ = shm + (buf) * MLA_KBUF; _Pragma("unroll") for (int i = 0; i < 3; ++i) *(LAS u32x4*)(kb_ + kkey[i] * MLA_KP + kch[i] * 16) = kreg[i]; \
        LAS char* vb_ = shm + 2 * MLA_KBUF + (buf) * MLA_VBUF + (8 * vc) * MLA_VP + 4 * vkp; \
        _Pragma("unroll") for (int j = 0; j < 4; ++j) { const unsigned a_ = vreg[0][j], b_ = vreg[1][j]; \
            *(LAS unsigned*)(vb_ + (2 * j) * MLA_VP) = (a_ & 0xffffu) | (b_ << 16); *(LAS unsigned*)(vb_ + (2 * j + 1) * MLA_VP) = (a_ >> 16) | (b_ & 0xffff0000u); } } while (0)
    f32x16 o[4];
#pragma unroll
    for (int d = 0; d < 4; ++d) o[d] = f32x16{};
    float mrun = -1e30f, lrun = 0.f;
    MLA_ISSUE(0); MLA_WRITE(0); __syncthreads();
    for (int t = 0; t < NT; ++t) {
        const int cur = t & 1;
        if (t + 1 < NT) MLA_ISSUE(t + 1);
        if (t * 64 <= qw + 31) {
            f32x16 s0 = f32x16{}, s1 = f32x16{};
            { const LAS char* kb = shm + cur * MLA_KBUF + r32 * MLA_KP + hi * 16;
              bf16x8 ka[2][6];
#pragma unroll
              for (int i = 0; i < 3; ++i) { ka[0][2 * i] = *(const LAS bf16x8*)(kb + i * 32); ka[0][2 * i + 1] = *(const LAS bf16x8*)(kb + 32 * MLA_KP + i * 32); }
              __builtin_amdgcn_sched_barrier(0);
#pragma unroll
              for (int bt = 0; bt < 4; ++bt) {
                  if (bt < 3) {
#pragma unroll
                      for (int i = 0; i < 3; ++i) { ka[(bt + 1) & 1][2 * i] = *(const LAS bf16x8*)(kb + (3 * (bt + 1) + i) * 32); ka[(bt + 1) & 1][2 * i + 1] = *(const LAS bf16x8*)(kb + 32 * MLA_KP + (3 * (bt + 1) + i) * 32); }
                  }
                  __builtin_amdgcn_sched_barrier(0);
#pragma unroll
                  for (int i = 0; i < 3; ++i) { s0 = MFMA32(ka[bt & 1][2 * i], qf[3 * bt + i], s0); s1 = MFMA32(ka[bt & 1][2 * i + 1], qf[3 * bt + i], s1); }
                  __builtin_amdgcn_sched_barrier(0);
              } }
            if (t * 64 + 63 > qw) {
                const int qq = qw + r32;
#pragma unroll
                for (int r = 0; r < 16; ++r) { const int kv = t * 64 + crow(r, hi); if (kv > qq) s0[r] = -INFINITY; if (kv + 32 > qq) s1[r] = -INFINITY; }
            }
            float mx = fmaxf(s0[0], s1[0]);
#pragma unroll
            for (int r = 1; r < 16; ++r) mx = fmaxf(mx, fmaxf(s0[r], s1[r]));
            mx = xmax32(mx);
            if (__builtin_amdgcn_ballot_w64(mx - mrun > 8.f) != 0ull) {
                const float mnew = fmaxf(mrun, mx); const float alpha = __builtin_amdgcn_exp2f(mrun - mnew); mrun = mnew;
                lrun *= alpha;
#pragma unroll
                for (int d = 0; d < 4; ++d) o[d] *= alpha;
            }
            float ps = 0.f;
#pragma unroll
            for (int r = 0; r < 16; ++r) { s0[r] = __builtin_amdgcn_exp2f(s0[r] - mrun); s1[r] = __builtin_amdgcn_exp2f(s1[r] - mrun); ps += s0[r] + s1[r]; }
            lrun += ps;
            u32x4 pw[4];
#pragma unroll
            for (int j = 0; j < 4; ++j) { pw[0][j] = cvtpk(s0[2 * j], s0[2 * j + 1]); pw[1][j] = cvtpk(s0[8 + 2 * j], s0[9 + 2 * j]); pw[2][j] = cvtpk(s1[2 * j], s1[2 * j + 1]); pw[3][j] = cvtpk(s1[8 + 2 * j], s1[9 + 2 * j]); }
            { const LAS char* vb = shm + 2 * MLA_KBUF + cur * MLA_VBUF + r32 * MLA_VP + hi * 8;
              u32x2 vlo[2][4], vhi[2][4];
#pragma unroll
              for (int d = 0; d < 4; ++d) { vlo[0][d] = *(const LAS u32x2*)(vb + d * 32 * MLA_VP); vhi[0][d] = *(const LAS u32x2*)(vb + d * 32 * MLA_VP + 16); }
              __builtin_amdgcn_sched_barrier(0);
#pragma unroll
              for (int j = 0; j < 4; ++j) {
                  if (j < 3) {
#pragma unroll
                      for (int d = 0; d < 4; ++d) { vlo[(j + 1) & 1][d] = *(const LAS u32x2*)(vb + d * 32 * MLA_VP + (j + 1) * 32); vhi[(j + 1) & 1][d] = *(const LAS u32x2*)(vb + d * 32 * MLA_VP + (j + 1) * 32 + 16); }
                  }
                  __builtin_amdgcn_sched_barrier(0);
#pragma unroll
                  for (int d = 0; d < 4; ++d) { const u32x4 va = {vlo[j & 1][d].x, vlo[j & 1][d].y, vhi[j & 1][d].x, vhi[j & 1][d].y};
                      o[d] = MFMA32(__builtin_bit_cast(bf16x8, va), __builtin_bit_cast(bf16x8, pw[j]), o[d]); }
                  __builtin_amdgcn_sched_barrier(0);
              } }
        }
        if (t + 1 < NT) MLA_WRITE(cur ^ 1);
        __syncthreads();
    }
#undef MLA_ISSUE
#undef MLA_WRITE
    lrun = xadd32(lrun);
    const float inv = 1.f / lrun; float ss = 0.f;
    const size_t row = rowbase + qw + r32;
    LAS char* ot = shm + wid * 8704;
#pragma unroll
    for (int d = 0; d < 4; ++d)
#pragma unroll
        for (int g = 0; g < 4; ++g) { const f32x4 v = {o[d][4 * g] * inv, o[d][4 * g + 1] * inv, o[d][4 * g + 2] * inv, o[d][4 * g + 3] * inv};
            ss += (v[0] * v[0] + v[1] * v[1]) + (v[2] * v[2] + v[3] * v[3]);
            u32x2 w; w.x = cvtpk(v[0], v[1]); w.y = cvtpk(v[2], v[3]); *(LAS u32x2*)(ot + r32 * 272 + (32 * d + 8 * g + 4 * hi) * 2) = w; }
    ss = xadd32(ss);
    if (hi == 0) ssB[row * 4 + h] = ss;
    asm volatile("s_waitcnt lgkmcnt(0)" ::: "memory");
    { const int rr = lane >> 4, ch = lane & 15;
      bf16_t* ob = AO + (rowbase + qw) * 1024 + 512 + h * 128 + ch * 8;
#pragma unroll
      for (int i = 0; i < 8; ++i) { const int ri = 4 * i + rr; *(u32x4*)(ob + (size_t)ri * 1024) = *(const LAS u32x4*)(ot + ri * 272 + ch * 16); } }
    asm volatile("s_waitcnt lgkmcnt(0)" ::: "memory");
    __syncthreads();
}

constexpr int BD_KP = 144, BD_VP = 776, BD_KBYTES = 384 * BD_KP, BD_VBYTES = 64 * BD_VP;
struct BandUnit { int b, head, d, rho, blk, pidx; };
template <bool FINAL> __device__ __forceinline__ BandUnit band_decode(int u) {
    BandUnit r;
    if constexpr (FINAL) { r.b = u >> 7; r.head = (u >> 4) & 7; r.d = 1; r.rho = 0; r.blk = u & 15; r.pidx = 0; }
    else if (u < 1024) { r.b = u >> 7; r.head = (u >> 4) & 7; r.d = 16; r.rho = u & 15; r.blk = 0; r.pidx = 0; }
    else { const int v = u - 1024; r.b = v >> 7; r.head = (v >> 4) & 7; r.d = 4; r.rho = (v >> 2) & 3; r.blk = v & 3; r.pidx = 1; }
    return r;
}
template <bool FINAL>
__device__ __forceinline__ void band_phase(LAS char* shm, const bf16_t* __restrict__ QA, const bf16_t* __restrict__ KA, const bf16_t* __restrict__ VA,
                                           bf16_t* OP, float* LSE, bf16_t* AO, float* ssA, int first, int nunits, int stride, int wv) {
    int tid_o = wv * 64 + lane_id(); asm volatile("" : "+v"(tid_o));
    const int tid = tid_o, lane = tid & 63, wid = __builtin_amdgcn_readfirstlane(tid >> 6), r32 = lane & 31, hi = lane >> 5;
    const int kk = tid >> 3, c8 = tid & 7;
    u32x4 kreg[6], vreg[3][2];
#define BD_ISSUE(U) do { const unsigned rb_ = (unsigned)(U).b * SEQ + (U).rho; const int p0_ = (U).blk * 256 - 128; const int k0_ = ((U).blk == 0) ? 2 : 0; \
        const bf16_t* kg_ = KA + (unsigned)(rb_ * 512 + (U).head * 64 + c8 * 8); const bf16_t* vg_ = VA + (unsigned)(rb_ * 512 + (U).head * 64 + c8 * 8); \
        _Pragma("unroll") for (int i = 0; i < 6; ++i) if (i >= k0_) kreg[i] = *(const u32x4*)(kg_ + (unsigned)((U).d * (p0_ + 64 * i + kk) * 512)); \
        _Pragma("unroll") for (int i = 0; i < 3; ++i) if (2 * i + 1 >= k0_) { const int kp_ = p0_ + 2 * (kk + 64 * i); \
            vreg[i][0] = *(const u32x4*)(vg_ + (unsigned)((U).d * kp_ * 512)); vreg[i][1] = *(const u32x4*)(vg_ + (unsigned)((U).d * (kp_ + 1) * 512)); } } while (0)
#define BD_WRITE(U) do { const int k0_ = ((U).blk == 0) ? 2 : 0; \
        _Pragma("unroll") for (int i = 0; i < 6; ++i) if (i >= k0_) *(LAS u32x4*)(shm + (64 * i + kk) * BD_KP + c8 * 16) = kreg[i]; \
        _Pragma("unroll") for (int i = 0; i < 3; ++i) if (2 * i + 1 >= k0_) { LAS char* vb_ = shm + BD_KBYTES + (8 * c8) * BD_VP + 4 * (kk + 64 * i); \
            _Pragma("unroll") for (int j = 0; j < 4; ++j) { const unsigned a_ = vreg[i][0][j], b_ = vreg[i][1][j]; \
                *(LAS unsigned*)(vb_ + (2 * j) * BD_VP) = (a_ & 0xffffu) | (b_ << 16); *(LAS unsigned*)(vb_ + (2 * j + 1) * BD_VP) = (a_ >> 16) | (b_ & 0xffff0000u); } } } while (0)
    int u = first; asm volatile("" : "+s"(u));
    BandUnit U = band_decode<FINAL>(u);
    BD_ISSUE(U);
    for (;;) {
        const int b = U.b, head = U.head, d = U.d, rho = U.rho, blk = U.blk, pidx = U.pidx;
        const unsigned rowbase = (unsigned)b * SEQ; const int P0 = blk * 256;
        const unsigned row = rowbase + rho + d * (P0 + wid * 32 + r32);
        bf16x8 qf[4];
        { const bf16_t* qp = QA + (unsigned)(row * 512 + head * 64 + hi * 8);
#pragma unroll
          for (int ks = 0; ks < 4; ++ks) qf[ks] = *(const bf16x8*)(qp + ks * 16); }
        BD_WRITE(U);
        __syncthreads();
        const int un = u + stride; const bool has_next = un < nunits;
        if (has_next) { U = band_decode<FINAL>(un); BD_ISSUE(U); }
        f32x16 o[2]; o[0] = f32x16{}; o[1] = f32x16{};
        float mrun = -1e30f, lrun = 0.f;
        const int k0 = (blk == 0) ? 2 : 0;
#pragma unroll 1
        for (int kap = k0; kap < 6; ++kap) {
            if (64 * kap >= 32 * wid - 63 && 64 * kap <= 32 * wid + 159) {
                f32x16 s0 = f32x16{}, s1 = f32x16{};
                { const LAS char* kb = shm + (64 * kap + r32) * BD_KP + hi * 16;
#pragma unroll
                  for (int ks = 0; ks < 4; ++ks) { const bf16x8 a0 = *(const LAS bf16x8*)(kb + ks * 32), a1 = *(const LAS bf16x8*)(kb + 32 * BD_KP + ks * 32);
                      s0 = MFMA32(a0, qf[ks], s0); s1 = MFMA32(a1, qf[ks], s1); } }
                { const int qrel = 32 * wid + r32; const int kb0 = 64 * kap - 128;
#pragma unroll
                  for (int r = 0; r < 16; ++r) { const int kr = kb0 + crow(r, hi); const int dist0 = qrel - kr, dist1 = dist0 - 32;
                      if (dist0 < 0 || dist0 > 128) s0[r] = -INFINITY; if (dist1 < 0 || dist1 > 128) s1[r] = -INFINITY; } }
                float mx = fmaxf(s0[0], s1[0]);
#pragma unroll
                for (int r = 1; r < 16; ++r) mx = fmaxf(mx, fmaxf(s0[r], s1[r]));
                mx = xmax32(mx);
                const float mnew = fmaxf(mrun, mx); const float alpha = __builtin_amdgcn_exp2f(mrun - mnew); mrun = mnew;
                float ps = 0.f;
#pragma unroll
                for (int r = 0; r < 16; ++r) { s0[r] = __builtin_amdgcn_exp2f(s0[r] - mnew); s1[r] = __builtin_amdgcn_exp2f(s1[r] - mnew); ps += s0[r] + s1[r]; }
                lrun = lrun * alpha + ps;
                o[0] *= alpha; o[1] *= alpha;
                u32x4 pw[4];
#pragma unroll
                for (int j = 0; j < 4; ++j) { pw[0][j] = cvtpk(s0[2 * j], s0[2 * j + 1]); pw[1][j] = cvtpk(s0[8 + 2 * j], s0[9 + 2 * j]); pw[2][j] = cvtpk(s1[2 * j], s1[2 * j + 1]); pw[3][j] = cvtpk(s1[8 + 2 * j], s1[9 + 2 * j]); }
                { const LAS char* vb = shm + BD_KBYTES + r32 * BD_VP + 128 * kap + hi * 8;
#pragma unroll
                  for (int dd = 0; dd < 2; ++dd)
#pragma unroll
                    for (int j = 0; j < 4; ++j) { const u32x2 lo = *(const LAS u32x2*)(vb + dd * 32 * BD_VP + j * 32), hh = *(const LAS u32x2*)(vb + dd * 32 * BD_VP + j * 32 + 16);
                        const u32x4 va = {lo.x, lo.y, hh.x, hh.y};
                        o[dd] = MFMA32(__builtin_bit_cast(bf16x8, va), __builtin_bit_cast(bf16x8, pw[j]), o[dd]); } }
            }
        }
        __syncthreads();
        lrun = xadd32(lrun);
        LAS char* ot = shm + wid * 9216;
        {
            float c3, c1 = 0.f, c2 = 0.f;
            if constexpr (!FINAL) { c3 = 1.f / lrun; if (hi == 0) LSE[(size_t)pidx * T_TOK * 8 + (unsigned)(row * 8 + head)] = mrun + __builtin_amdgcn_logf(lrun); }
            else {
                const float l1 = LSE[(unsigned)(row * 8 + head)], l2 = LSE[(size_t)T_TOK * 8 + (unsigned)(row * 8 + head)];
                const float M = fmaxf(mrun, fmaxf(l1, l2));
                const float w3 = __builtin_amdgcn_exp2f(mrun - M), w1 = __builtin_amdgcn_exp2f(l1 - M), w2 = __builtin_amdgcn_exp2f(l2 - M);
                const float inv = 1.f / (lrun * w3 + w1 + w2);
                c3 = w3 * inv; c1 = w1 * inv; c2 = w2 * inv;
            }
            if (hi == 0) *(LAS f32x4*)(ot + 8704 + r32 * 16) = (f32x4){c3, c1, c2, 0.f};
#pragma unroll
            for (int dd = 0; dd < 2; ++dd)
#pragma unroll
                for (int g = 0; g < 4; ++g) *(LAS f32x4*)(ot + r32 * 272 + (32 * dd + 8 * g + 4 * hi) * 4) = (f32x4){o[dd][4 * g], o[dd][4 * g + 1], o[dd][4 * g + 2], o[dd][4 * g + 3]};
        }
        asm volatile("s_waitcnt lgkmcnt(0)" ::: "memory");
        {
            const int rr = lane >> 4, ch = lane & 15;
            const unsigned rowq0 = rowbase + rho + d * (P0 + wid * 32);
#pragma unroll
            for (int i = 0; i < 8; ++i) {
                const int ri = 4 * i + rr; const unsigned rowg = rowq0 + d * ri;
                const f32x4 v = *(const LAS f32x4*)(ot + ri * 272 + ch * 16), cc = *(const LAS f32x4*)(ot + 8704 + ri * 16);
                if constexpr (!FINAL) {
                    st_bf16x4(OP + (size_t)pidx * T_TOK * 512 + (unsigned)(rowg * 512 + head * 64 + ch * 4), v * cc[0]);
                } else {
                    const u32x2 a = *(const u32x2*)(OP + (unsigned)(rowg * 512 + head * 64 + ch * 4)), bb = *(const u32x2*)(OP + (size_t)T_TOK * 512 + (unsigned)(rowg * 512 + head * 64 + ch * 4));
                    const f32x4 w = {v[0] * cc[0] + bf_lo(a.x) * cc[1] + bf_lo(bb.x) * cc[2], v[1] * cc[0] + bf_hi(a.x) * cc[1] + bf_hi(bb.x) * cc[2],
                                     v[2] * cc[0] + bf_lo(a.y) * cc[1] + bf_lo(bb.y) * cc[2], v[3] * cc[0] + bf_hi(a.y) * cc[1] + bf_hi(bb.y) * cc[2]};
                    st_bf16x4(AO + (unsigned)(rowg * 1024 + head * 64 + ch * 4), w);
                    float ss = (w[0] * w[0] + w[1] * w[1]) + (w[2] * w[2] + w[3] * w[3]);
                    ss += swz_xor<1>(ss); ss += swz_xor<2>(ss); ss += swz_xor<4>(ss); ss += swz_xor<8>(ss);
                    if (ch == 0) ssA[(unsigned)(rowg * 8 + head)] = ss;
                }
            }
        }
        __syncthreads();
        if (!has_next) break;
        u = un;
    }
#undef BD_ISSUE
#undef BD_WRITE
}

#define XB_TMO      128
#define XB_XCNT(j)  (256  + 64 * (j))
#define XB_XSUB(j)  (1280 + 64 * (j))
#define XB_XGEN(j)  (2304 + 64 * (j))
#define XB_TOP      3328
#define XB_TOPGEN   3392
#define XCD_BAR_WORDS 3456
#define XB_SPIN_CAP (1u << 18)
__device__ __forceinline__ unsigned xb_ld(unsigned* p)              { return __hip_atomic_load(p, __ATOMIC_RELAXED, __HIP_MEMORY_SCOPE_AGENT); }
__device__ __forceinline__ unsigned xb_add(unsigned* p, unsigned v) { return __hip_atomic_fetch_add(p, v, __ATOMIC_RELAXED, __HIP_MEMORY_SCOPE_AGENT); }
__device__ __forceinline__ unsigned xb_xcc_id() { return (unsigned)__builtin_amdgcn_s_getreg((3 << 11) | 20) & 0xFu; }
#define XB_SPIN(cond, bar) do { unsigned _sp = 0; while (cond) { __builtin_amdgcn_s_sleep(1); \
    if ((++_sp & 255u) == 0u) { if (xb_ld(&(bar)[XB_TMO])) break; if (_sp > XB_SPIN_CAP) { atomicAdd(&(bar)[XB_TMO], 1u); break; } } } } while (0)
struct XcdBarrier { unsigned* bar; unsigned x; volatile LAS unsigned* st; int wv; };
__device__ __forceinline__ XcdBarrier xcd_barrier_post(unsigned* bar, volatile LAS unsigned* st, int wv) {
    XcdBarrier b; b.bar = bar; b.x = xb_xcc_id(); b.st = st; b.wv = wv;
    if (wv == 0 && lane_id() == 0) (void)xb_add(&bar[XB_XCNT(b.x)], 1u);
    return b;
}
__device__ __forceinline__ void xcd_barrier_complete(unsigned* bar, unsigned x, unsigned& nloc, unsigned& nx) {
    const unsigned G = gridDim.x * gridDim.y * gridDim.z;
    unsigned sum, cnt, mine, sp = 0u;
    for (;;) {
        sum = 0u; cnt = 0u; mine = 0u;
#pragma unroll
        for (unsigned j = 0; j < 16; ++j) { const unsigned c = xb_ld(&bar[XB_XCNT(j)]); sum += c; cnt += (c > 0u) ? 1u : 0u; mine = (j == x) ? c : mine; }
        if (sum == G) break;
        __builtin_amdgcn_s_sleep(1);
        if ((++sp & 255u) == 0u) { if (xb_ld(&bar[XB_TMO])) break; if (sp > XB_SPIN_CAP) { atomicAdd(&bar[XB_TMO], 1u); break; } }
    }
    nloc = mine > 0u ? mine : 1u; nx = cnt > 0u ? cnt : 1u;
}
__device__ __forceinline__ void xcd_barrier(const XcdBarrier& b) {
    asm volatile("s_waitcnt vmcnt(0)" ::: "memory");
    __syncthreads();
    if (b.wv == 0 && lane_id() == 0) {
        unsigned* bar = b.bar;
        __builtin_amdgcn_s_waitcnt(0);
        unsigned nloc = b.st[0], nx = b.st[1];
        if (nloc == 0u) { xcd_barrier_complete(bar, b.x, nloc, nx); b.st[0] = nloc; b.st[1] = nx; }
        const unsigned old = xb_add(&bar[XB_XSUB(b.x)], 1u);
        const unsigned gen = old / nloc;
        if (old + 1u == (gen + 1u) * nloc) {
            __builtin_amdgcn_fence(__ATOMIC_RELEASE, "agent");
            asm volatile("s_waitcnt vmcnt(0)" ::: "memory");
            const unsigned og = xb_add(&bar[XB_TOP], 1u);
            const unsigned tg = og / nx;
            if (og + 1u == (tg + 1u) * nx) xb_add(&bar[XB_TOPGEN], 1u);
            else XB_SPIN(xb_ld(&bar[XB_TOPGEN]) == tg, bar);
            __builtin_amdgcn_fence(__ATOMIC_ACQUIRE, "agent");
            xb_add(&bar[XB_XGEN(b.x)], 1u);
            asm volatile("s_waitcnt vmcnt(0)" ::: "memory");
        } else {
            XB_SPIN(xb_ld(&bar[XB_XGEN(b.x)]) == gen, bar);
            __builtin_amdgcn_fence(__ATOMIC_ACQUIRE, "agent");
            asm volatile("s_waitcnt vmcnt(0)" ::: "memory");
        }
    }
    __syncthreads();
}

struct Args { const float* in[15]; float* out; unsigned char* ws; };
typedef const __attribute__((address_space(4))) unsigned char* kptr_t;
#define KA_PTR(idx) ({ kptr_t p_ = (kptr_t)__builtin_amdgcn_kernarg_segment_ptr(); asm volatile("" : "+s"(p_)); *(const __attribute__((address_space(4))) unsigned long long*)(p_ + 8 * (idx)); })
#define GASP __attribute__((address_space(1)))
#define K_IN(idx) ((const float*)(const GASP float*)KA_PTR(idx))
#define K_OUT() ((float*)(GASP float*)KA_PTR(15))
#define K_WS() ((unsigned char*)(GASP unsigned char*)KA_PTR(16))

#define W_BASE(L) (((L) == 0) ? (K_WS() + WS_W) : ((unsigned char*)K_OUT() + (size_t)((L) - 1) * W_LAYER_BYTES))
#define CONV_ALL() do { \
        int tid_ = wv * 64 + lane_id(); asm volatile("" : "+v"(tid_)); const int lane_ = tid_ & 63, gw_ = bx * 8 + wv; \
        constexpr int I_IN = (IN_PAD / 64) * (DM / 64), I_UQ = (768 / 64) * (256 / 64), I_UKV = (1024 / 64) * (128 / 64), I_O = (DM / 64) * (DM / 64), I_1 = (DFF / 64) * (DM / 64), I_2 = (DM / 64) * (DFF / 64); \
        constexpr int I_LAYER = I_IN + I_UQ + I_UKV + I_O + I_1 + I_2; \
        _Pragma("unroll 1") for (int it = gw_; it < DEPTH * I_LAYER; it += NGW) { const int l_ = it / I_LAYER; int r = it - l_ * I_LAYER; unsigned char* wl = W_BASE(l_); \
            if (r < I_IN) { conv_item<1>(K_IN(1) + (size_t)l_ * DM * IN_COLS, DM, IN_COLS, (bf16_t*)(wl + WO_IN), nullptr, nullptr, 0, r / (DM / 64), r % (DM / 64), lane_); continue; } r -= I_IN; \
            if (r < I_UQ) { conv_item<2>(K_IN(4) + (size_t)l_ * 256 * 768, 256, 768, (bf16_t*)(wl + WO_UQ), K_IN(2) + l_ * 256, K_IN(2) + l_ * 256, 256, r / 4, r % 4, lane_); continue; } r -= I_UQ; \
            if (r < I_UKV) { conv_item<0>(K_IN(5) + (size_t)l_ * 128 * 1024, 128, 1024, (bf16_t*)(wl + WO_UKV), K_IN(3) + l_ * 128, K_IN(3) + l_ * 128, 128, r / 2, r % 2, lane_); continue; } r -= I_UKV; \
            if (r < I_O) { conv_item<0>(K_IN(8) + (size_t)l_ * DM * DM, DM, DM, (bf16_t*)(wl + WO_O), K_IN(6) + l_ * 512, K_IN(7) + l_ * 512, 512, r / (DM / 64), r % (DM / 64), lane_); continue; } r -= I_O; \
            if (r < I_1) { conv_item<0>(K_IN(11) + (size_t)l_ * DM * DFF, DM, DFF, (bf16_t*)(wl + WO_1), nullptr, nullptr, 0, r / (DM / 64), r % (DM / 64), lane_); continue; } r -= I_1; \
            conv_item<0>(K_IN(12) + (size_t)l_ * DFF * DM, DFF, DM, (bf16_t*)(wl + WO_2), nullptr, nullptr, 0, r / (DFF / 64), r % (DFF / 64), lane_); } } while (0)

__global__ void __launch_bounds__(512, 2) fwd_mega(Args args_unused) {
    extern __shared__ __attribute__((aligned(16))) unsigned char lds_raw[];
    LAS unsigned char* lds = (LAS unsigned char*)lds_raw;
    cg::grid_group grid = cg::this_grid();
    const int G = gridDim.x, bx = blockIdx.x;
    const int NGW = G * 8;
    const int wv = __builtin_amdgcn_readfirstlane(threadIdx.x >> 6);

    volatile LAS unsigned* bst = (volatile LAS unsigned*)(lds + 131072 + 512);
    if (wv == 0 && lane_id() < 2) bst[lane_id()] = 0u;
    __syncthreads();
    XcdBarrier xbar = xcd_barrier_post((unsigned*)K_WS(), bst, wv);
#if USE_XCD_BARRIER
#define GRID_SYNC() xcd_barrier(xbar)
#else
#define GRID_SYNC() grid.sync()
#endif

    if (PH_MASK & 1) {
        int tid = wv * 64 + lane_id(); asm volatile("" : "+v"(tid)); const int lane = tid & 63, wave = wv, gw = bx * 8 + wave;
        unsigned char* ws = K_WS();
        float* cs = (float*)(ws + WS_ROPE);
        for (int idx = bx * 512 + tid; idx < SEQ * 32; idx += G * 512) {
            const int pos = idx >> 5, i = idx & 31;
            double f = 1.0; for (int k = 0; k < i; ++k) f *= 0.74989420933245583;
            const double ang = (double)pos * f;
            const double kk = __builtin_rint(ang * 0.15915494309189535);
            const double r = ang - kk * 6.283185307179586477;
            const double r2 = r * r;
            double sn = 1.0, cn = 1.0;
#pragma unroll 1
            for (int n = 14; n >= 1; --n) { sn = 1.0 - sn * r2 / (double)((2 * n) * (2 * n + 1)); cn = 1.0 - cn * r2 / (double)((2 * n - 1) * (2 * n)); }
            cs[idx] = (float)cn; cs[SEQ * 32 + idx] = (float)(sn * r);
        }
        CONV_ALL();
        const float* x_in = K_IN(0); bf16_t* XB = (bf16_t*)(ws + WS_XB);
        for (unsigned i = (unsigned)bx * 512 + tid; i < (unsigned)(T_TOK * DM / 8); i += (unsigned)G * 512) {
            const f32x4 a = ((const f32x4*)x_in)[2 * i], b = ((const f32x4*)x_in)[2 * i + 1];
            u32x4 w; w.x = cvtpk(a[0], a[1]); w.y = cvtpk(a[2], a[3]); w.z = cvtpk(b[0], b[1]); w.w = cvtpk(b[2], b[3]);
            ((u32x4*)XB)[i] = w;
        }
    }
    grid.sync();

#pragma unroll 1
    for (int l = 0; l < DEPTH; ++l) {
        for (int rep_ = 0; rep_ < ((DUP_MASK & 2) ? 2 : 1); ++rep_) if (PH_MASK & 2) {
            unsigned char* ws = K_WS(); unsigned char* wl = W_BASE(l);
            pg8::Gemm g{(const bf16_t*)(ws + WS_XB), (const bf16_t*)(wl + WO_IN), T_TOK, IN_PAD, DM}; pg8::StaticOrder S; S.init(T_TOK, IN_PAD, G, bx);
            EpiIn E{(bf16_t*)(ws + WS_QA), (bf16_t*)(ws + WS_KA), (bf16_t*)(ws + WS_VA), (bf16_t*)(ws + WS_CQ), (bf16_t*)(ws + WS_CKV), (bf16_t*)(ws + WS_KM),
                    (float*)(ws + WS_PCQ), (float*)(ws + WS_PCKV), (const float*)(ws + WS_ROPE)};
            pg8::gemm_phase<EpiIn, pg8::StaticOrder, true, true>(lds, g, S, E, wv);
        }
        GRID_SYNC();
        for (int rep_ = 0; rep_ < ((DUP_MASK & 4) ? 2 : 1); ++rep_) if (PH_MASK & 4) {
            unsigned char* ws = K_WS(); unsigned char* wl = W_BASE(l);
            float* rsq = (float*)(ws + WS_RSQ); const float* pcq = (const float*)(ws + WS_PCQ);
            pg8::Gemm g{(const bf16_t*)(ws + WS_CQ), (const bf16_t*)(wl + WO_UQ), T_TOK, 768, 256}; pg8::StaticOrder S; S.init(T_TOK, 768, G, bx);
            { int tid = wv * 64 + lane_id(); asm volatile("" : "+v"(tid)); Unit u; for (int i = 0; S.next(i, u); ++i) if (tid < 256) { const int row = u.pm * 256 + tid; const f32x4 pp = *(const f32x4*)(pcq + row * 4);
                  rsq[row] = QSCALE_M / sqrtf(((pp[0] + pp[1]) + (pp[2] + pp[3])) * (1.f / 256.f) + RMS_EPS); } }
            __syncthreads();
            EpiUpQ E{(bf16_t*)(ws + WS_QM), rsq, (const float*)(ws + WS_ROPE)};
            pg8::gemm_phase<EpiUpQ, pg8::StaticOrder, true, true>(lds, g, S, E, wv);
        }
        for (int rep_ = 0; rep_ < ((DUP_MASK & 8) ? 2 : 1); ++rep_) if (PH_MASK & 8) {
            unsigned char* ws = K_WS(); unsigned char* wl = W_BASE(l);
            float* rskv = (float*)(ws + WS_RSKV); const float* pckv = (const float*)(ws + WS_PCKV);
            pg8::Gemm g{(const bf16_t*)(ws + WS_CKV), (const bf16_t*)(wl + WO_UKV), T_TOK, 1024, 128}; pg8::StaticOrder S; S.init(T_TOK, 1024, G, bx);
            { int tid = wv * 64 + lane_id(); asm volatile("" : "+v"(tid)); Unit u; for (int i = 0; S.next(i, u); ++i) if (tid < 256) { const int row = u.pm * 256 + tid; const f32x4 pp = *(const f32x4*)(pckv + row * 4);
                  rskv[row] = 1.f / sqrtf(((pp[0] + pp[1]) + (pp[2] + pp[3])) * (1.f / 128.f) + RMS_EPS); } }
            __syncthreads();
            EpiUpKV E{(bf16_t*)(ws + WS_KM), (bf16_t*)(ws + WS_VM), rskv};
            pg8::gemm_phase<EpiUpKV, pg8::StaticOrder, true, true>(lds, g, S, E, wv);
        }
        for (int rep_ = 0; rep_ < ((DUP_MASK & 1024) ? 2 : 1); ++rep_) if (PH_MASK & 32) {
            unsigned char* ws = K_WS();
            band_phase<false>((LAS char*)lds, (const bf16_t*)(ws + WS_QA), (const bf16_t*)(ws + WS_KA), (const bf16_t*)(ws + WS_VA), (bf16_t*)(ws + WS_XB), (float*)(ws + WS_LSE),
                              nullptr, nullptr, bx, 2048, G, wv);
            __syncthreads();
        }
        GRID_SYNC();
#pragma unroll 1
        for (int step = 0; step < 2; ++step) {
            const bool do_mla = (step == 0) != (((bx >> 7) & 1) != 0);
            if (do_mla) {
                unsigned char* ws = K_WS();
                const int vb = (G % 8 == 0) ? (bx % 8) * (G / 8) + bx / 8 : bx;
                for (int p = vb; p < 256; p += G) {
                    const int bh = p >> 3, s = p & 7;
                    mla_unit((LAS char*)lds, (const bf16_t*)(ws + WS_QM), (const bf16_t*)(ws + WS_KM), (const bf16_t*)(ws + WS_VM), (bf16_t*)(ws + WS_AO), (float*)(ws + WS_SSB), bh >> 2, bh & 3, 15 - s, wv);
                    mla_unit((LAS char*)lds, (const bf16_t*)(ws + WS_QM), (const bf16_t*)(ws + WS_KM), (const bf16_t*)(ws + WS_VM), (bf16_t*)(ws + WS_AO), (float*)(ws + WS_SSB), bh >> 2, bh & 3, s, wv);
                }
            } else {
                unsigned char* ws = K_WS();
                band_phase<true>((LAS char*)lds, (const bf16_t*)(ws + WS_QA), (const bf16_t*)(ws + WS_KA), (const bf16_t*)(ws + WS_VA), (bf16_t*)(ws + WS_XB), (float*)(ws + WS_LSE),
                                 (bf16_t*)(ws + WS_AO), (float*)(ws + WS_SSA), bx, 1024, G, wv);
                __syncthreads();
            }
        }
        GRID_SYNC();
        if (PH_MASK & 64) {
            unsigned char* ws = K_WS(); unsigned char* wl = W_BASE(l);
            bf16_t* out = (bf16_t*)(ws + WS_ZB);
            ResLn R; R.ln = (l > 0); R.x32 = K_IN(0); R.zb = (const bf16_t*)out; R.mu = (const float*)(ws + WS_MU2); R.rs = (const float*)(ws + WS_RS2);
            { const float* gsrc = K_IN(13) + (l > 0 ? l - 1 : 0) * DM; const float* bsrc = K_IN(14) + (l > 0 ? l - 1 : 0) * DM; const int t_ = wv * 64 + lane_id();
              ((LAS float*)(lds + LDS_GB_OFF))[t_] = gsrc[t_]; ((LAS float*)(lds + LDS_GB_OFF))[t_ + 512] = gsrc[t_ + 512];
              ((LAS float*)(lds + LDS_GB_OFF + 4096))[t_] = bsrc[t_]; ((LAS float*)(lds + LDS_GB_OFF + 4096))[t_ + 512] = bsrc[t_ + 512]; }
            float* rsr = (float*)(ws + WS_RSR); float* rsbv = (float*)(ws + WS_RSB); const float* ssA = (const float*)(ws + WS_SSA); const float* ssB = (const float*)(ws + WS_SSB);
            pg8::Gemm g{(const bf16_t*)(ws + WS_AO), (const bf16_t*)(wl + WO_O), T_TOK, DM, DM}; pg8::StaticOrder S; S.init(T_TOK, DM, G, bx);
            { int tid = wv * 64 + lane_id(); asm volatile("" : "+v"(tid)); Unit u; for (int i = 0; S.next(i, u); ++i) if (tid < 256) { const int row = u.pm * 256 + tid;
                  const f32x4 a = *(const f32x4*)(ssA + row * 8), b = *(const f32x4*)(ssA + row * 8 + 4), c = *(const f32x4*)(ssB + row * 4);
                  const float ra = 1.f / sqrtf((((a[0] + a[1]) + (a[2] + a[3])) + ((b[0] + b[1]) + (b[2] + b[3]))) * (1.f / 512.f) + RMS_EPS);
                  const float rb = 1.f / sqrtf(((c[0] + c[1]) + (c[2] + c[3])) * (1.f / 512.f) + RMS_EPS);
                  rsr[row] = ra / rb; rsbv[row] = rb; } }
            __syncthreads();
            EpiOut E{R, out, rsr, rsbv, (LAS const unsigned char*)(lds + LDS_GB_OFF)};
            pg8::gemm_phase<EpiOut, pg8::StaticOrder, true, true>(lds, g, S, E, wv);
        }
        GRID_SYNC();
        if (PH_MASK & 128) { unsigned char* ws = K_WS(); ln_rows<true>((const bf16_t*)(ws + WS_ZB), nullptr, (bf16_t*)(ws + WS_XB), (float*)(ws + WS_MU1), (float*)(ws + WS_RS1), K_IN(9) + l * DM, K_IN(10) + l * DM, NGW, wv); }
        GRID_SYNC();
        for (int rep_ = 0; rep_ < ((DUP_MASK & 256) ? 2 : 1); ++rep_) if (PH_MASK & 256) {
            unsigned char* ws = K_WS(); unsigned char* wl = W_BASE(l);
            pg8::Gemm g{(const bf16_t*)(ws + WS_XB), (const bf16_t*)(wl + WO_1), T_TOK, DFF, DM}; pg8::StaticOrder S; S.init(T_TOK, DFF, G, bx);
            EpiFfn1 E{(bf16_t*)(ws + WS_HF)};
            pg8::gemm_phase<EpiFfn1, pg8::StaticOrder, true, true>(lds, g, S, E, wv);
        }
        GRID_SYNC();
        if (PH_MASK & 512) {
            unsigned char* ws = K_WS(); unsigned char* wl = W_BASE(l);
            pg8::Gemm g{(const bf16_t*)(ws + WS_HF), (const bf16_t*)(wl + WO_2), T_TOK, DM, DFF}; pg8::StaticOrder S; S.init(T_TOK, DM, G, bx);
            bf16_t* out = (bf16_t*)(ws + WS_ZB);
            ResLn R; R.ln = 1; R.x32 = nullptr; R.zb = (const bf16_t*)out; R.mu = (const float*)(ws + WS_MU1); R.rs = (const float*)(ws + WS_RS1);
            { const float* gsrc = K_IN(9) + l * DM; const float* bsrc = K_IN(10) + l * DM; const int t_ = wv * 64 + lane_id();
              ((LAS float*)(lds + LDS_GB_OFF))[t_] = gsrc[t_]; ((LAS float*)(lds + LDS_GB_OFF))[t_ + 512] = gsrc[t_ + 512];
              ((LAS float*)(lds + LDS_GB_OFF + 4096))[t_] = bsrc[t_]; ((LAS float*)(lds + LDS_GB_OFF + 4096))[t_ + 512] = bsrc[t_ + 512]; }
            __syncthreads();
            EpiFfn2 E{R, out, (LAS const unsigned char*)(lds + LDS_GB_OFF)};
            pg8::gemm_phase<EpiFfn2, pg8::StaticOrder, true, true>(lds, g, S, E, wv);
        }
        GRID_SYNC();
        if (PH_MASK & 128) { unsigned char* ws = K_WS();
            if (l + 1 < DEPTH) ln_rows<true>((const bf16_t*)(ws + WS_ZB), nullptr, (bf16_t*)(ws + WS_XB), (float*)(ws + WS_MU2), (float*)(ws + WS_RS2), K_IN(13) + l * DM, K_IN(14) + l * DM, NGW, wv);
            else ln_rows<false>((const bf16_t*)(ws + WS_ZB), K_OUT(), nullptr, nullptr, nullptr, K_IN(13) + l * DM, K_IN(14) + l * DM, NGW, wv); }
        GRID_SYNC();
    }
}

extern "C" void kernel_launch(void* const* d_in, const int* in_sizes, int n_in, void* d_out, int out_size, void* d_ws, size_t ws_size, hipStream_t stream) {
    static int grid = 0;
    if (grid == 0) {
        if (n_in != 15 || out_size != T_TOK * DM || ws_size < WS_END) { fprintf(stderr, "kernel_launch: unexpected shapes (n_in %d out %d ws %zu)\n", n_in, out_size, ws_size); grid = -1; return; }
        int dev = 0, cus = 0, per_cu = 0;
        hipGetDevice(&dev);
        hipDeviceGetAttribute(&cus, hipDeviceAttributeMultiprocessorCount, dev);
        if (hipFuncSetAttribute((const void*)fwd_mega, hipFuncAttributeMaxDynamicSharedMemorySize, LDS_BYTES) != hipSuccess) { fprintf(stderr, "kernel_launch: hipFuncSetAttribute failed\n"); grid = -1; return; }
        if (hipOccupancyMaxActiveBlocksPerMultiprocessor(&per_cu, (const void*)fwd_mega, 512, LDS_BYTES) != hipSuccess || per_cu < 1) { fprintf(stderr, "kernel_launch: occupancy query gave %d\n", per_cu); per_cu = 1; }
        (void)hipGetLastError();
        grid = cus * per_cu;
        fprintf(stderr, "kernel_launch: grid %d (cus %d x %d)\n", grid, cus, per_cu);
    }
    if (grid < 0) return;
    if (hipMemsetAsync((char*)d_ws + WS_CTL, 0, CTL_ZERO_BYTES, stream) != hipSuccess) { fprintf(stderr, "kernel_launch: memset failed\n"); return; }
    Args a{};
    for (int i = 0; i < 15; ++i) a.in[i] = (const float*)d_in[i];
    a.out = (float*)d_out; a.ws = (unsigned char*)d_ws;
    void* kargs[] = {&a};
    hipError_t e = hipLaunchCooperativeKernel((const void*)fwd_mega, dim3(grid), dim3(512), kargs, LDS_BYTES, stream);
    if (e != hipSuccess) fprintf(stderr, "kernel_launch: cooperative launch failed: %s (grid %d)\n", hipGetErrorString(e), grid);
}
```
